# Optimizing an MI355X kernel written in HIP

```python
import math
import jax
import jax.numpy as jnp
from jax import lax
import numpy as np

D_MODEL = 2048
BATCH = 4
SEQ = 4096
DEPTH = 2

CHUNK = 64
Q_BLOCK = 128
EPS = 1e-6
N_BRANCH = 3
BRANCH_WIDTH = D_MODEL // 2
A_NOPE = 128
A_ROPE = 64
A_V = 128
A_HEADS = BRANCH_WIDTH // A_V
A_Q_RANK = D_MODEL // 4
A_KV_RANK = D_MODEL // 8
A_ROPE_THETA = 10000.0
B_DK = 64
B_DV = 128
B_HEADS = BRANCH_WIDTH // B_DV
B_ROT = B_DK // 4
B_ROPE_THETA = 500000.0
C_DH = 128
C_HEADS = BRANCH_WIDTH // C_DH
C_LEFT_CHUNKS = 8
C_BAND = (C_LEFT_CHUNKS + 1) * CHUNK
C_REL_MAX = 128
C_N_REL = (CHUNK - 1) + C_REL_MAX + 1

IN_SPLITS = (A_Q_RANK, A_KV_RANK, A_ROPE, BRANCH_WIDTH,
             B_HEADS * 2 * B_DK, B_HEADS * 2 * B_DK, B_HEADS * B_DV, BRANCH_WIDTH,
             C_HEADS * C_DH, C_HEADS * C_DH, C_HEADS * C_DH, BRANCH_WIDTH,
             N_BRANCH * D_MODEL)
D_IN = sum(IN_SPLITS)
SPLIT_POINTS = tuple(int(v) for v in np.cumsum(IN_SPLITS)[:-1])

kernel_name = "hybrid_mla_diff_chunkband_block"


def _rmsnorm(x, g):
    xf = x.astype(jnp.float32)
    y = xf * lax.rsqrt(jnp.mean(xf * xf, axis=-1, keepdims=True) + EPS)
    return (y * g.astype(jnp.float32)).astype(x.dtype)


def _rope_tables(s, dim, theta):
    inv = 1.0 / (jnp.float32(theta) ** (jnp.arange(0, dim, 2, dtype=jnp.float32) / dim))
    ang = jnp.arange(s, dtype=jnp.float32)[:, None] * inv[None, :]
    return jnp.cos(ang), jnp.sin(ang)


def _rope(x, cos, sin):
    half = x.shape[-1] // 2
    shape = (1, x.shape[1]) + (1,) * (x.ndim - 3) + (half,)
    c = cos.reshape(shape).astype(x.dtype)
    sn = sin.reshape(shape).astype(x.dtype)
    x1, x2 = x[..., :half], x[..., half:]
    return jnp.concatenate([x1 * c - x2 * sn, x2 * c + x1 * sn], axis=-1)


def _partial_rope(x, cos, sin):
    return jnp.concatenate([_rope(x[..., :B_ROT], cos, sin), x[..., B_ROT:]], axis=-1)


def _to_blocks(t, size):
    b, s = t.shape[0], t.shape[1]
    return jnp.moveaxis(t.reshape((b, s // size, size) + t.shape[2:]), 1, 0)


def _from_blocks(t):
    t = jnp.moveaxis(t, 0, 1)
    return t.reshape((t.shape[0], t.shape[1] * t.shape[2]) + t.shape[3:])


def _chunk_causal_mask(q_start, q_len, k_len):
    q_chunk = (q_start + jnp.arange(q_len)) // CHUNK
    k_chunk = jnp.arange(k_len) // CHUNK
    return k_chunk[None, :] <= q_chunk[:, None]


def _mla_attention(qn, qr, kn, kr, v):
    s_len = kn.shape[1]
    scale = (A_NOPE + A_ROPE) ** -0.5

    def block(args):
        qn_b, qr_b, i = args
        sc = (jnp.einsum('bqhd,bkhd->bhqk', qn_b, kn)
              + jnp.einsum('bqhr,bkr->bhqk', qr_b, kr)).astype(jnp.float32) * scale
        mask = _chunk_causal_mask(i * Q_BLOCK, Q_BLOCK, s_len)
        p = jax.nn.softmax(jnp.where(mask, sc, -jnp.inf), axis=-1)
        return jnp.einsum('bhqk,bkhd->bqhd', p.astype(v.dtype), v)

    n_blocks = s_len // Q_BLOCK
    out = lax.map(block, (_to_blocks(qn, Q_BLOCK), _to_blocks(qr, Q_BLOCK), jnp.arange(n_blocks)))
    return _from_blocks(out)


def _diff_attention(q, k, v, lam):
    s_len = k.shape[1]
    scale = B_DK ** -0.5

    def block(args):
        q_b, i = args
        sc = jnp.einsum('bqhcd,bkhcd->bhcqk', q_b, k).astype(jnp.float32) * scale
        mask = _chunk_causal_mask(i * Q_BLOCK, Q_BLOCK, s_len)
        p = jax.nn.softmax(jnp.where(mask, sc, -jnp.inf), axis=-1)
        a = p[:, :, 0] - lam * p[:, :, 1]
        return jnp.einsum('bhqk,bkhe->bqhe', a.astype(v.dtype), v)

    n_blocks = s_len // Q_BLOCK
    out = lax.map(block, (_to_blocks(q, Q_BLOCK), jnp.arange(n_blocks)))
    return _from_blocks(out)


def _chunk_band_attention(q, k, v, rel_bias):
    s_len = q.shape[1]
    pad = C_LEFT_CHUNKS * CHUNK
    widths = ((0, 0), (pad, 0), (0, 0), (0, 0))
    k_pad = jnp.pad(k, widths)
    v_pad = jnp.pad(v, widths)
    q_idx = jnp.arange(CHUNK)[:, None]
    k_idx = jnp.arange(C_BAND)[None, :]
    rel = jnp.clip(pad + q_idx - k_idx, -(CHUNK - 1), C_REL_MAX) + (CHUNK - 1)
    bias = rel_bias.astype(jnp.float32)[:, rel]
    key_offset = jnp.arange(C_BAND) - pad
    scale = C_DH ** -0.5

    def one_chunk(c):
        start = c * CHUNK
        q_c = lax.dynamic_slice_in_dim(q, start, CHUNK, axis=1)
        k_c = lax.dynamic_slice_in_dim(k_pad, start, C_BAND, axis=1)
        v_c = lax.dynamic_slice_in_dim(v_pad, start, C_BAND, axis=1)
        sc = jnp.einsum('bqhd,bkhd->bhqk', q_c, k_c).astype(jnp.float32) * scale + bias
        valid = (start + key_offset) >= 0
        p = jax.nn.softmax(jnp.where(valid, sc, -jnp.inf), axis=-1)
        return jnp.einsum('bhqk,bkhd->bqhd', p.astype(v.dtype), v_c)

    out = lax.map(one_chunk, jnp.arange(s_len // CHUNK))
    return _from_blocks(out)


def _hybrid_layer(x, layer_idx, rope_a, rope_b, g_pre, w_in, a_g_cq, a_g_ckv, a_w_uq, a_w_ukv,
                  a_g_q, a_g_k, b_g_q, b_g_k, b_lam, b_g_sub, c_g_q, c_g_k, c_rel_bias,
                  w_branch, w_out):
    b, s, _ = x.shape
    h = _rmsnorm(x, g_pre)
    u = h @ w_in
    (a_cq, a_ckv, a_kr, a_z, b_q, b_k, b_v, b_z,
     c_q, c_k, c_v, c_z, gate_logits) = jnp.split(u, SPLIT_POINTS, axis=-1)

    qa = (_rmsnorm(a_cq, a_g_cq) @ a_w_uq).reshape(b, s, A_HEADS, A_NOPE + A_ROPE)
    kva = (_rmsnorm(a_ckv, a_g_ckv) @ a_w_ukv).reshape(b, s, A_HEADS, A_NOPE + A_V)
    qn = _rmsnorm(qa[..., :A_NOPE], a_g_q[:A_NOPE])
    qr = _rope(_rmsnorm(qa[..., A_NOPE:], a_g_q[A_NOPE:]), *rope_a)
    kn = _rmsnorm(kva[..., :A_NOPE], a_g_k[:A_NOPE])
    kr = _rope(_rmsnorm(a_kr, a_g_k[A_NOPE:]), *rope_a)
    o_a = _mla_attention(qn, qr, kn, kr, kva[..., A_NOPE:]).reshape(b, s, BRANCH_WIDTH)

    bq = _partial_rope(_rmsnorm(b_q.reshape(b, s, B_HEADS, 2, B_DK), b_g_q), *rope_b)
    bk = _partial_rope(_rmsnorm(b_k.reshape(b, s, B_HEADS, 2, B_DK), b_g_k), *rope_b)
    bv = b_v.reshape(b, s, B_HEADS, B_DV)
    lam_init = 0.8 - 0.6 * math.exp(-0.3 * layer_idx)
    lf = b_lam.astype(jnp.float32)
    lam = jnp.exp(jnp.sum(lf[0] * lf[1])) - jnp.exp(jnp.sum(lf[2] * lf[3])) + lam_init
    ob = _rmsnorm(_diff_attention(bq, bk, bv, lam), b_g_sub) * (1.0 - lam_init)
    o_b = ob.reshape(b, s, BRANCH_WIDTH)

    cq = _rmsnorm(c_q.reshape(b, s, C_HEADS, C_DH), c_g_q)
    ck = _rmsnorm(c_k.reshape(b, s, C_HEADS, C_DH), c_g_k)
    cv = c_v.reshape(b, s, C_HEADS, C_DH)
    o_c = _chunk_band_attention(cq, ck, cv, c_rel_bias).reshape(b, s, BRANCH_WIDTH)

    gates = jax.nn.sigmoid(gate_logits.astype(jnp.float32)).astype(x.dtype).reshape(b, s, N_BRANCH, D_MODEL)
    branches = (o_a * jax.nn.silu(a_z), o_b * jax.nn.silu(b_z), o_c * jax.nn.silu(c_z))
    y = gates[:, :, 0] * (branches[0] @ w_branch[0])
    for n in range(1, N_BRANCH):
        y = y + gates[:, :, n] * (branches[n] @ w_branch[n])
    return y @ w_out


def setup_inputs(seed: int = 0) -> dict:
    key = jax.random.key(seed)
    ks = jax.random.split(key, 18)

    def nrm(k, shape, scale):
        return jax.random.normal(k, shape, jnp.float32) * scale

    def gain(k, shape):
        return 1.0 + 0.02 * jax.random.normal(k, shape, jnp.float32)

    return {
        "x": nrm(ks[0], (BATCH, SEQ, D_MODEL), 1.0),
        "g_pre": gain(ks[1], (DEPTH, D_MODEL)),
        "w_in": nrm(ks[2], (DEPTH, D_MODEL, D_IN), D_MODEL ** -0.5),
        "a_g_cq": gain(ks[3], (DEPTH, A_Q_RANK)),
        "a_g_ckv": gain(ks[4], (DEPTH, A_KV_RANK)),
        "a_w_uq": nrm(ks[5], (DEPTH, A_Q_RANK, A_HEADS * (A_NOPE + A_ROPE)), A_Q_RANK ** -0.5),
        "a_w_ukv": nrm(ks[6], (DEPTH, A_KV_RANK, A_HEADS * (A_NOPE + A_V)), A_KV_RANK ** -0.5),
        "a_g_q": gain(ks[7], (DEPTH, A_NOPE + A_ROPE)),
        "a_g_k": gain(ks[8], (DEPTH, A_NOPE + A_ROPE)),
        "b_g_q": gain(ks[9], (DEPTH, B_DK)),
        "b_g_k": gain(ks[10], (DEPTH, B_DK)),
        "b_lam": nrm(ks[11], (DEPTH, 4, B_DK), 0.1),
        "b_g_sub": gain(ks[12], (DEPTH, B_DV)),
        "c_g_q": gain(ks[13], (DEPTH, C_DH)),
        "c_g_k": gain(ks[14], (DEPTH, C_DH)),
        "c_rel_bias": nrm(ks[15], (DEPTH, C_HEADS, C_N_REL), 0.2),
        "w_branch": nrm(ks[16], (DEPTH, N_BRANCH, BRANCH_WIDTH, D_MODEL), BRANCH_WIDTH ** -0.5),
        "w_out": nrm(ks[17], (DEPTH, D_MODEL, D_MODEL), D_MODEL ** -0.5),
    }


def reference(x, g_pre, w_in, a_g_cq, a_g_ckv, a_w_uq, a_w_ukv, a_g_q, a_g_k, b_g_q, b_g_k,
              b_lam, b_g_sub, c_g_q, c_g_k, c_rel_bias, w_branch, w_out):
    s = x.shape[1]
    rope_a = _rope_tables(s, A_ROPE, A_ROPE_THETA)
    rope_b = _rope_tables(s, B_ROT, B_ROPE_THETA)
    for l in range(DEPTH):
        x = x + _hybrid_layer(x, l, rope_a, rope_b, g_pre[l], w_in[l], a_g_cq[l], a_g_ckv[l],
                              a_w_uq[l], a_w_ukv[l], a_g_q[l], a_g_k[l], b_g_q[l], b_g_k[l],
                              b_lam[l], b_g_sub[l], c_g_q[l], c_g_k[l], c_rel_bias[l],
                              w_branch[l], w_out[l])
    return x
```

```cpp
#include <hip/hip_runtime.h>
#include <hip/hip_cooperative_groups.h>
#include <cstdio>
#include <cstdint>
namespace cg = cooperative_groups;
#ifndef PH_MASK
#define PH_MASK 0xFFFF
#endif
#define PH(k) ((PH_MASK >> (k)) & 1)

#define DI __device__ __forceinline__
#define LAS __attribute__((address_space(3)))
typedef unsigned short bf16_t;
typedef short bf16x8 __attribute__((ext_vector_type(8)));
typedef short s16x4 __attribute__((ext_vector_type(4)));
typedef float f32x4 __attribute__((ext_vector_type(4)));
typedef float f32x16 __attribute__((ext_vector_type(16)));
typedef unsigned u32x4 __attribute__((ext_vector_type(4)));

constexpr int T = 16384, SEQ = 4096, DM = 2048, DIN = 16192, NU = 16384, DEPTH = 2;
constexpr int UC_CQ = 0, UC_CKV = 512, UC_AZ = 1024, UC_BQ = 2048, UC_BK = 3072, UC_BV = 4096, UC_BZ = 5120,
              UC_CQ2 = 6144, UC_CK = 7168, UC_CV = 8192, UC_CZ = 9216, UC_GATE = 10240;
constexpr float EPS = 1e-6f, LOG2E = 1.4426950408889634f;

constexpr size_t al256(size_t x) { return (x + 255) / 256 * 256; }
constexpr size_t WS_CTL = 0;
constexpr size_t WS_BAR = 1024;
constexpr size_t WS_CTL_BYTES = 32768;
constexpr size_t WS_ROPE = WS_CTL_BYTES;
constexpr size_t WS_WIN = al256(WS_ROPE + (size_t)SEQ * 80 * 4);
constexpr size_t WS_WUQ = WS_WIN + (size_t)NU * DM * 2;
constexpr size_t WS_WUKV = WS_WUQ + (size_t)1536 * 512 * 2;
constexpr size_t WS_WB = WS_WUKV + (size_t)2048 * 256 * 2;
constexpr size_t WS_WO = WS_WB + (size_t)3 * 2048 * 1024 * 2;
constexpr size_t WS_U = WS_WO + (size_t)2048 * 2048 * 2;
constexpr size_t WS_R1 = WS_U + (size_t)T * NU * 2;
constexpr size_t WS_QA = WS_R1 + (size_t)T * 2048 * 2;
constexpr size_t WS_KVA = WS_QA + (size_t)T * 1536 * 2;
constexpr size_t WS_KA = WS_KVA + (size_t)T * 2048 * 2;
constexpr size_t WS_OB = WS_KA + (size_t)T * 1536 * 2;
constexpr size_t WS_G = WS_OB + (size_t)T * 2048 * 2;
constexpr size_t WS_END = WS_G + (size_t)T * 3072 * 2;

constexpr int LDS_BYTES = 147456;
constexpr int ATT_MISC = 4 * 16384 + 3 * 24576;
constexpr int ATT_BIAS = ATT_MISC + 2048;
constexpr int ATT_QW = ATT_BIAS + 1024;

DI unsigned pk2(float lo, float hi) { unsigned r; asm volatile("v_cvt_pk_bf16_f32 %0, %1, %2" : "=v"(r) : "v"(lo), "v"(hi)); return r; }
DI bf16_t f2bf(float x) { unsigned u = __float_as_uint(x); u += 0x7fffu + ((u >> 16) & 1u); return (bf16_t)(u >> 16); }
DI void unpack8(const u32x4 v, float (&f)[8]) {
    f[0] = __uint_as_float(v.x << 16); f[1] = __uint_as_float(v.x & 0xffff0000u);
    f[2] = __uint_as_float(v.y << 16); f[3] = __uint_as_float(v.y & 0xffff0000u);
    f[4] = __uint_as_float(v.z << 16); f[5] = __uint_as_float(v.z & 0xffff0000u);
    f[6] = __uint_as_float(v.w << 16); f[7] = __uint_as_float(v.w & 0xffff0000u);
}
DI u32x4 pack8(const float (&f)[8]) { u32x4 o; o.x = pk2(f[0], f[1]); o.y = pk2(f[2], f[3]); o.z = pk2(f[4], f[5]); o.w = pk2(f[6], f[7]); return o; }
DI void load8f(const float* p, float (&f)[8]) { const f32x4 a = *(const f32x4*)p, b = *(const f32x4*)(p + 4); f[0] = a.x; f[1] = a.y; f[2] = a.z; f[3] = a.w; f[4] = b.x; f[5] = b.y; f[6] = b.z; f[7] = b.w; }
DI float sumsq8(const float (&f)[8]) { float s = 0.f;
#pragma unroll
    for (int j = 0; j < 8; ++j) s += f[j] * f[j];
    return s; }
DI float xsum(float v, int lo, int hi) {
#pragma unroll
    for (int o = lo; o <= hi; o <<= 1) v += __shfl_xor(v, o);
    return v; }
DI float sigmoidf_(float v) { return __builtin_amdgcn_rcpf(1.f + __expf(-v)); }

namespace pg8 {
constexpr int BM = 256, BK = 64, HALF = 128, HTB = HALF * BK * 2, STAGE_BYTES = 8 * HTB, NXCD = 8, WGM = 16;
DI int lds_byte(int r, int c) { const int st = (r >> 4) * 2 + (c >> 5), rr = r & 15, cc = c & 31, ob = rr * 64 + cc * 2; return st * 1024 + (ob ^ (((ob >> 9) & 1) << 5)); }
DI void stage_rc(int b, int& R, int& C) { const int st = b / 1024, sb = b % 1024, swz = sb ^ (((sb >> 9) & 1) << 5); R = (st >> 1) * 16 + swz / 64; C = (st & 1) * 32 + (swz % 64) / 2; }
DI int perm32(int rho) { const int n = rho >> 4, i = rho & 15; return 8 * (i >> 2) + 4 * n + (i & 3); }

struct Unit { int pm, pn, sub; size_t aoff, boff; };
struct Gemm { const bf16_t* A; const bf16_t* Bt; int lda, K; };

DI void tile_of(int wgid, int nM, int nN, int& pm, int& pn) {
    const int nwg = nM * nN;
    { const int q = nwg / NXCD, r = nwg % NXCD, xcd = wgid % NXCD, off = wgid / NXCD; wgid = (xcd < r ? xcd * (q + 1) : r * (q + 1) + (xcd - r) * q) + off; }
    const int nig = WGM * nN, gid = wgid / nig, fm = gid * WGM, gsz = (nM - fm) < WGM ? (nM - fm) : WGM;
    pm = fm + ((wgid % nig) % gsz); pn = (wgid % nig) / gsz;
}
struct Sched {
    int nM, nN, nwg, G, c, lda, K, triple;
    DI void init(int M, int N, int lda_, int K_, int triple_, int G_, int c_) { nM = M / BM; nN = N / BM; nwg = nM * nN; G = G_; c = c_; lda = lda_; K = K_; triple = triple_; }
    DI bool next(int i, Unit& u) const {
        const int j = triple ? i / 3 : i; const long L = (long)j * G + c; if (L >= nwg) return false;
        tile_of((int)L, nM, nN, u.pm, u.pn); u.sub = triple ? i - 3 * j : 0;
        if (triple) { u.aoff = ((size_t)u.pm * BM * 3072 + (size_t)u.sub * 1024) * 2; u.boff = ((size_t)u.sub * 2048 + (size_t)u.pn * BM) * 1024 * 2; }
        else { u.aoff = (size_t)u.pm * BM * lda * 2; u.boff = (size_t)u.pn * BM * K * 2; }
        return true;
    }
};

struct Epi {
    static constexpr bool PERM = true;
    int mode, act_by_pn, ldc; bf16_t* O; const bf16_t* U; float* YB; const float* Xin; float* Out;
    bf16_t* KAo; const float* gk; LAS float* part;
    DI void operator()(const f32x4 (&acc)[2][2][4][2], const Unit& u, int wr, int wc, int fr, int fq) const {
        const int pn = u.pn;
        const int row0 = u.pm * BM + wr * 64 + fr, col0 = pn * BM + wc * 32 + 8 * fq;
        if (mode == 0) {
            const int act = !act_by_pn ? 0 : ((pn >= 40) ? 2 : (((pn >= 4 && pn < 8) || (pn >= 20 && pn < 24) || (pn >= 36 && pn < 40)) ? 1 : 0));
#pragma unroll
            for (int ai = 0; ai < 2; ++ai)
#pragma unroll
                for (int m = 0; m < 4; ++m) { bf16_t* rowp = O + (size_t)(row0 + ai * HALF + m * 16) * ldc + col0;
#pragma unroll
                    for (int bj = 0; bj < 2; ++bj) { f32x4 v0 = acc[ai][bj][m][0], v1 = acc[ai][bj][m][1];
                        if (act == 1) {
#pragma unroll
                            for (int j = 0; j < 4; ++j) { v0[j] = v0[j] * sigmoidf_(v0[j]); v1[j] = v1[j] * sigmoidf_(v1[j]); }
                        } else if (act == 2) {
#pragma unroll
                            for (int j = 0; j < 4; ++j) { v0[j] = sigmoidf_(v0[j]); v1[j] = sigmoidf_(v1[j]); }
                        }
                        u32x4 w; w.x = pk2(v0[0], v0[1]); w.y = pk2(v0[2], v0[3]); w.z = pk2(v1[0], v1[1]); w.w = pk2(v1[2], v1[3]);
                        *(u32x4*)(rowp + bj * HALF) = w; } }
        } else if (mode == 4) {
            float ss[2][4];
#pragma unroll
            for (int ai = 0; ai < 2; ++ai)
#pragma unroll
                for (int m = 0; m < 4; ++m) { const f32x4 a0 = acc[ai][0][m][0], a1 = acc[ai][0][m][1];
                    float v = (a0.x * a0.x + a0.y * a0.y) + (a0.z * a0.z + a0.w * a0.w) + (a1.x * a1.x + a1.y * a1.y) + (a1.z * a1.z + a1.w * a1.w);
                    v += __shfl_xor(v, 16); v += __shfl_xor(v, 32); ss[ai][m] = v; }
            if (fq == 0) {
#pragma unroll
                for (int ai = 0; ai < 2; ++ai)
#pragma unroll
                    for (int m = 0; m < 4; ++m) part[(ai * HALF + wr * 64 + m * 16 + fr) * 4 + wc] = ss[ai][m];
            }
            asm volatile("s_waitcnt lgkmcnt(0)" ::: "memory");
            __builtin_amdgcn_s_barrier();
            asm volatile("" ::: "memory");
            float gk8[8]; load8f(gk + wc * 32 + 8 * fq, gk8);
#pragma unroll
            for (int ai = 0; ai < 2; ++ai)
#pragma unroll
                for (int m = 0; m < 4; ++m) { const int rl = ai * HALF + wr * 64 + m * 16 + fr; const size_t row = (size_t)(u.pm * BM + rl);
                    const f32x4 pv = *(const LAS f32x4*)(part + rl * 4);
                    const float rs = 1.0f / sqrtf(((pv.x + pv.y) + (pv.z + pv.w)) * (1.0f / 128) + EPS);
                    { const f32x4 v0 = acc[ai][0][m][0], v1 = acc[ai][0][m][1];
                      u32x4 w; w.x = pk2(v0[0] * rs * gk8[0], v0[1] * rs * gk8[1]); w.y = pk2(v0[2] * rs * gk8[2], v0[3] * rs * gk8[3]);
                      w.z = pk2(v1[0] * rs * gk8[4], v1[1] * rs * gk8[5]); w.w = pk2(v1[2] * rs * gk8[6], v1[3] * rs * gk8[7]);
                      *(u32x4*)(KAo + row * 1536 + pn * 192 + wc * 32 + 8 * fq) = w; }
                    { const f32x4 v0 = acc[ai][1][m][0], v1 = acc[ai][1][m][1];
                      u32x4 w; w.x = pk2(v0[0], v0[1]); w.y = pk2(v0[2], v0[3]); w.z = pk2(v1[0], v1[1]); w.w = pk2(v1[2], v1[3]);
                      *(u32x4*)(O + row * ldc + col0 + HALF) = w; } }
        } else if (mode == 2) {
#pragma unroll
            for (int ai = 0; ai < 2; ++ai) { u32x4 gv[4][2];
#pragma unroll
                for (int m = 0; m < 4; ++m)
#pragma unroll
                    for (int bj = 0; bj < 2; ++bj) gv[m][bj] = *(const u32x4*)(U + (size_t)(row0 + ai * HALF + m * 16) * NU + UC_GATE + 2 * 2048 + col0 + bj * HALF);
#pragma unroll
                for (int m = 0; m < 4; ++m) { const size_t row = (size_t)(row0 + ai * HALF + m * 16);
#pragma unroll
                    for (int bj = 0; bj < 2; ++bj) { const int col = col0 + bj * HALF;
                        float g[8]; unpack8(gv[m][bj], g);
#pragma unroll
                        for (int j = 0; j < 8; ++j) g[j] = fmaxf(g[j], 1e-30f);
                        const f32x4 a0 = acc[ai][bj][m][0], a1 = acc[ai][bj][m][1];
                        u32x4 w; w.x = pk2(a0[0] * g[0], a0[1] * g[1]); w.y = pk2(a0[2] * g[2], a0[3] * g[3]); w.z = pk2(a1[0] * g[4], a1[1] * g[5]); w.w = pk2(a1[2] * g[6], a1[3] * g[7]);
                        *(u32x4*)(O + row * DM + col) = w; } }
                __builtin_amdgcn_sched_barrier(0); }
        } else {
#pragma unroll
            for (int ai = 0; ai < 2; ++ai) { f32x4 xv[4][2][2];
#pragma unroll
                for (int m = 0; m < 4; ++m)
#pragma unroll
                    for (int bj = 0; bj < 2; ++bj)
#pragma unroll
                        for (int n = 0; n < 2; ++n) xv[m][bj][n] = __builtin_nontemporal_load((const f32x4*)(Xin + (size_t)(row0 + ai * HALF + m * 16) * DM + col0 + bj * HALF + n * 4));
#pragma unroll
                for (int m = 0; m < 4; ++m)
#pragma unroll
                    for (int bj = 0; bj < 2; ++bj)
#pragma unroll
                        for (int n = 0; n < 2; ++n) *(f32x4*)(Out + (size_t)(row0 + ai * HALF + m * 16) * DM + col0 + bj * HALF + n * 4) = xv[m][bj][n] + acc[ai][bj][m][n];
                __builtin_amdgcn_sched_barrier(0); }
        }
    }
    DI void rescale(f32x4 (&acc)[2][2][4][2], const Unit& u, int seg, int wr, int wc, int fr, int fq) const {
        int row0 = u.pm * BM + wr * 64 + fr, col0 = u.pn * BM + wc * 32 + 8 * fq;
        asm volatile("" : "+v"(row0), "+v"(col0));
#pragma unroll
        for (int ai = 0; ai < 2; ++ai)
#pragma unroll
        for (int mh = 0; mh < 2; ++mh) { u32x4 rr[2][4];
#pragma unroll
            for (int mm = 0; mm < 2; ++mm) { const bf16_t* gp = U + (size_t)(row0 + ai * HALF + (mh * 2 + mm) * 16) * NU + UC_GATE + (seg - 1) * 2048 + col0;
                rr[mm][0] = *(const u32x4*)(gp); rr[mm][1] = *(const u32x4*)(gp + HALF); rr[mm][2] = *(const u32x4*)(gp + 2048); rr[mm][3] = *(const u32x4*)(gp + 2048 + HALF); }
            asm volatile("s_waitcnt vmcnt(0)" ::: "memory");
#pragma unroll
            for (int mm = 0; mm < 2; ++mm)
#pragma unroll
                for (int bj = 0; bj < 2; ++bj) { const int m = mh * 2 + mm;
                    float g[8], gn[8]; unpack8(rr[mm][bj], g); unpack8(rr[mm][2 + bj], gn);
#pragma unroll
                    for (int j = 0; j < 8; ++j) g[j] = fmaxf(g[j], 1e-30f) * __builtin_amdgcn_rcpf(fmaxf(gn[j], 1e-30f));
                    f32x4 a0 = acc[ai][bj][m][0], a1 = acc[ai][bj][m][1];
                    a0.x *= g[0]; a0.y *= g[1]; a0.z *= g[2]; a0.w *= g[3];
                    a1.x *= g[4]; a1.y *= g[5]; a1.z *= g[6]; a1.w *= g[7];
                    acc[ai][bj][m][0] = a0; acc[ai][bj][m][1] = a1; }
            __builtin_amdgcn_sched_barrier(0); }
    }
};

DI void gemm_phase(LAS unsigned char* lds, const Gemm g, const Sched& S, const Epi& E) {
    int tid_ = threadIdx.x; asm volatile("" : "+v"(tid_));
    const int tid = tid_, wid = __builtin_amdgcn_readfirstlane(tid >> 6), lane = tid & 63, wr = wid >> 2, wc = wid & 3, fr = lane & 15, fq = lane >> 4;
    const int K = g.K, lda = g.lda, nt = K / BK;
    unsigned voffA[2], voffB[2];
#pragma unroll
    for (int i = 0; i < 2; ++i) { int R, C; stage_rc(tid * 16 + i * 8192, R, C); const int Rb = Epi::PERM ? ((R & ~31) + perm32(R & 31)) : R;
        voffA[i] = (unsigned)(R * lda + C) * 2u; voffB[i] = (unsigned)(Rb * K + C) * 2u; }
    const size_t kstep = (size_t)(BK * 2);
    const size_t hstepA = (size_t)HALF * lda * 2, hstepB = (size_t)HALF * K * 2;
    const unsigned ldsw = (unsigned)wid * 1024u;
    const int aoff = lds_byte(wr * 64 + fr, fq * 8), boff = lds_byte(wc * 32 + fr, fq * 8);
#define PG8_SA(b, h) (((b) * 2 + (h)) * HTB)
#define PG8_SB(b, h) ((4 + (b) * 2 + (h)) * HTB)
#define PG8_STAGE(bufoff, gbase, voff) do { _Pragma("unroll") for (int _i = 0; _i < 2; ++_i) \
        __builtin_amdgcn_global_load_lds((const unsigned*)((const char*)(gbase) + (voff)[_i]), (LAS unsigned*)(lds + (bufoff) + ldsw + _i * 8192), 16, 0, 0); } while (0)
#define PG8_LDA(dst, b, h) do { _Pragma("unroll") for (int m = 0; m < 4; ++m) _Pragma("unroll") for (int k = 0; k < 2; ++k) dst[m][k] = *(const LAS bf16x8*)(lds + PG8_SA(b, h) + aoff + m * 2048 + k * 1024); } while (0)
#define PG8_LDB(dst, b, h) do { _Pragma("unroll") for (int n = 0; n < 2; ++n) _Pragma("unroll") for (int k = 0; k < 2; ++k) dst[n][k] = *(const LAS bf16x8*)(lds + PG8_SB(b, h) + boff + n * 2048 + k * 1024); } while (0)
#define PG8_MMA(ai, bj, At, Bt) do { __builtin_amdgcn_s_setprio(1); _Pragma("unroll") for (int m = 0; m < 4; ++m) _Pragma("unroll") for (int n = 0; n < 2; ++n) _Pragma("unroll") for (int k = 0; k < 2; ++k) \
        acc[ai][bj][m][n] = __builtin_amdgcn_mfma_f32_16x16x32_bf16(Bt[n][k], At[m][k], acc[ai][bj][m][n], 0, 0, 0); __builtin_amdgcn_s_setprio(0); } while (0)
#define PG8_WAIT_V(n) asm volatile("s_waitcnt vmcnt(" #n ")" ::: "memory")
#define PG8_WAIT_L(n) asm volatile("s_waitcnt lgkmcnt(" #n ")" ::: "memory")
#define PG8_BAR __builtin_amdgcn_s_barrier()
#define PG8_SCHED __builtin_amdgcn_sched_barrier(0)
    Unit cur, nxt; int ui = 0;
    if (!S.next(0, cur)) return;
    f32x4 acc[2][2][4][2];
#pragma unroll
    for (int a = 0; a < 2; ++a)
#pragma unroll
        for (int b = 0; b < 2; ++b)
#pragma unroll
            for (int m = 0; m < 4; ++m)
#pragma unroll
                for (int n = 0; n < 2; ++n) acc[a][b][m][n] = (f32x4){0.f, 0.f, 0.f, 0.f};
    bf16x8 At[4][2], B0[2][2], B1[2][2];
    const char* cA = (const char*)g.A + cur.aoff; const char* cB = (const char*)g.Bt + cur.boff;
    PG8_STAGE(PG8_SB(0, 0), cB, voffB); PG8_STAGE(PG8_SB(0, 1), cB + hstepB, voffB); PG8_STAGE(PG8_SA(0, 0), cA, voffA); PG8_STAGE(PG8_SA(0, 1), cA + hstepA, voffA);
    if (wr == 1) PG8_BAR;
    PG8_WAIT_V(2); PG8_BAR;
    PG8_STAGE(PG8_SB(1, 0), cB + kstep, voffB); PG8_STAGE(PG8_SA(1, 0), cA + kstep, voffA); PG8_STAGE(PG8_SB(1, 1), cB + hstepB + kstep, voffB);
    PG8_WAIT_V(6); PG8_BAR;
    for (;;) {
        const bool has_next = S.next(ui + 1, nxt);
        const char* nA = has_next ? (const char*)g.A + nxt.aoff : cA; const char* nB = has_next ? (const char*)g.Bt + nxt.boff : cB;
        for (int t = 0; t < nt; t += 2) {
            if (E.mode == 2 && (t == 16 || t == 32)) E.rescale(acc, cur, t >> 4, wr, wc, fr, fq);
            const bool last = (t == nt - 2);
            const char* a1 = cA + (size_t)(t + 1) * kstep;
            const char* a2 = last ? nA : cA + (size_t)(t + 2) * kstep; const char* b2 = last ? nB : cB + (size_t)(t + 2) * kstep;
            const char* a3 = a2 + kstep; const char* b3 = b2 + kstep;
            PG8_LDB(B0, 0, 0); PG8_LDB(B1, 0, 1); PG8_SCHED; PG8_LDA(At, 0, 0); PG8_STAGE(PG8_SA(1, 1), a1 + hstepA, voffA);
            PG8_WAIT_V(8); PG8_WAIT_L(0); PG8_BAR; PG8_MMA(0, 0, At, B0); PG8_MMA(0, 1, At, B1); PG8_BAR; PG8_SCHED;
            PG8_LDA(At, 0, 1); PG8_STAGE(PG8_SB(0, 0), b2, voffB); PG8_STAGE(PG8_SB(0, 1), b2 + hstepB, voffB); PG8_STAGE(PG8_SA(0, 0), a2, voffA);
            PG8_WAIT_V(8); PG8_WAIT_L(0); PG8_BAR; PG8_MMA(1, 0, At, B0); PG8_MMA(1, 1, At, B1); PG8_BAR; PG8_SCHED;
            PG8_LDB(B0, 1, 0); PG8_LDB(B1, 1, 1); PG8_SCHED; PG8_LDA(At, 1, 0); PG8_STAGE(PG8_SA(0, 1), a2 + hstepA, voffA);
            PG8_WAIT_V(8); PG8_WAIT_L(0); PG8_BAR; PG8_MMA(0, 0, At, B0); PG8_MMA(0, 1, At, B1); PG8_BAR; PG8_SCHED;
            PG8_LDA(At, 1, 1); PG8_STAGE(PG8_SB(1, 0), b3, voffB); PG8_STAGE(PG8_SB(1, 1), b3 + hstepB, voffB); PG8_STAGE(PG8_SA(1, 0), a3, voffA);
            PG8_WAIT_V(8); PG8_WAIT_L(0); PG8_BAR; PG8_MMA(1, 0, At, B0); PG8_MMA(1, 1, At, B1); PG8_BAR; PG8_SCHED;
        }
        if (wr == 0) PG8_BAR;
        E(acc, cur, wr, wc, fr, fq);
        if (!has_next) break;
#pragma unroll
        for (int a = 0; a < 2; ++a)
#pragma unroll
            for (int b = 0; b < 2; ++b)
#pragma unroll
                for (int m = 0; m < 4; ++m)
#pragma unroll
                    for (int n = 0; n < 2; ++n) acc[a][b][m][n] = (f32x4){0.f, 0.f, 0.f, 0.f};
        cur = nxt; cA = nA; cB = nB; ++ui;
        if (wr == 1) PG8_BAR;
    }
    PG8_WAIT_V(0);
    PG8_BAR;
#undef PG8_SA
#undef PG8_SB
#undef PG8_STAGE
#undef PG8_LDA
#undef PG8_LDB
#undef PG8_MMA
#undef PG8_WAIT_V
#undef PG8_WAIT_L
#undef PG8_BAR
#undef PG8_SCHED
}
}

DI int crow(int r, int hi) { return (r & 3) + 8 * (r >> 2) + 4 * hi; }
DI int v_st(int k, int c) { const int kk = (k & ~0xC) | ((k & 4) << 1) | ((k & 8) >> 1); return ((kk >> 3) * 4 + (c >> 5)) * 512 + ((kk & 7) * 32 + (c & 31)) * 2; }
DI int v_rd_base(int lane) { return ((lane & 3) << 3) | (((lane >> 2) & 3) << 6) | (((lane >> 4) & 1) << 5) | (((lane >> 5) & 1) << 8); }
constexpr int v_rd_off(int d0, int ks, int half) { return d0 * 512 + ks * 4096 + half * 2048; }
template <int OFF> DI s16x4 tr_read(int vb) { s16x4 r; asm volatile("ds_read_b64_tr_b16 %0, %1 offset:%2" : "=&v"(r) : "v"(vb), "i"(OFF) : "memory"); return r; }
template <int D0> DI void pv_one(f32x16& od, int vb, bf16x8 pa0, bf16x8 pa1, bf16x8 pa2, bf16x8 pa3) {
    const s16x4 l0 = tr_read<v_rd_off(D0, 0, 0)>(vb), h0 = tr_read<v_rd_off(D0, 0, 1)>(vb), l1 = tr_read<v_rd_off(D0, 1, 0)>(vb), h1 = tr_read<v_rd_off(D0, 1, 1)>(vb);
    const s16x4 l2 = tr_read<v_rd_off(D0, 2, 0)>(vb), h2 = tr_read<v_rd_off(D0, 2, 1)>(vb), l3 = tr_read<v_rd_off(D0, 3, 0)>(vb), h3 = tr_read<v_rd_off(D0, 3, 1)>(vb);
    asm volatile("s_waitcnt lgkmcnt(0)" ::: "memory"); __builtin_amdgcn_sched_barrier(0);
#define PK(L, H) (bf16x8){L[0], L[1], L[2], L[3], H[0], H[1], H[2], H[3]}
    od = __builtin_amdgcn_mfma_f32_32x32x16_bf16(pa0, PK(l0, h0), od, 0, 0, 0);
    od = __builtin_amdgcn_mfma_f32_32x32x16_bf16(pa1, PK(l1, h1), od, 0, 0, 0);
    od = __builtin_amdgcn_mfma_f32_32x32x16_bf16(pa2, PK(l2, h2), od, 0, 0, 0);
    od = __builtin_amdgcn_mfma_f32_32x32x16_bf16(pa3, PK(l3, h3), od, 0, 0, 0);
#undef PK
}
template <int DQK> DI int kswz(int row, int cb) { return row * (DQK * 2) + (cb ^ ((row & 7) << 4)); }

template <int DQK, bool BIAS, int ldq, int ldk, int ldv, int ldo>
DI void attn_unit(const float* __restrict__ gq, const float* __restrict__ ropec, const float* __restrict__ ropes, const int pos0,
                  const bf16_t* __restrict__ Qb, const bf16_t* __restrict__ Kb, const bf16_t* __restrict__ Vb, bf16_t* __restrict__ Ob,
                  const int blk_lo, const int blk_hi, const int cw, const float C, LAS unsigned char* lds,
                  const int epi, const bf16_t* __restrict__ Zb, const bf16_t* __restrict__ O0b, const float lam, const float post, const float* __restrict__ gsub) {
    constexpr int NKC = DQK / 64, ND = DQK / 16, SHV = 16384, SHK = 64 * DQK * 2, KOFF = 4 * SHV, RB = DQK * 2;
    constexpr float THR_L2 = 6.0f;
    int tid_ = threadIdx.x; asm volatile("" : "+v"(tid_));
    const int tid = tid_, wid = __builtin_amdgcn_readfirstlane(tid >> 6), lane = tid & 63, r32 = lane & 31, hi = lane >> 5;
    const bool late = wid >= 4;
    LAS float* misc = (LAS float*)(lds + ATT_MISC) + wid * 64; LAS float* li_l = misc; LAS float* al_l = misc + 32;
    const LAS float* bias_l = (const LAS float*)(lds + ATT_BIAS);
    const int w_lo = BIAS ? (cw > 8 ? cw - 8 : 0) : 0, w_hi = cw;
    float m_reg = -1e30f, l_reg = 0.f;
    f32x16 o[4];
#pragma unroll
    for (int d = 0; d < 4; ++d)
#pragma unroll
        for (int r = 0; r < 16; ++r) o[d][r] = 0.f;
    bf16x8 qr[ND];
    { const bf16_t* Qw = Qb + (size_t)(wid * 32 + r32) * ldq + hi * 8;
#pragma unroll
      for (int d0 = 0; d0 < ND; ++d0) qr[d0] = *(const bf16x8*)(Qw + d0 * 16);
      { const int pos = pos0 + wid * 32 + r32;
        float qf[ND][8]; float ssn = 0.f, ssr = 0.f;
#pragma unroll
        for (int d0 = 0; d0 < ND; ++d0) { unpack8(__builtin_bit_cast(u32x4, qr[d0]), qf[d0]); const float sq = sumsq8(qf[d0]); if (DQK == 192 && d0 >= 8) ssr += sq; else ssn += sq; }
        { auto rr = __builtin_amdgcn_permlane32_swap(__float_as_uint(ssn), __float_as_uint(ssn), false, false); ssn = __uint_as_float(rr[0]) + __uint_as_float(rr[1]); }
        if (DQK == 192) { auto rr = __builtin_amdgcn_permlane32_swap(__float_as_uint(ssr), __float_as_uint(ssr), false, false); ssr = __uint_as_float(rr[0]) + __uint_as_float(rr[1]); }
        const float rsn = 1.0f / sqrtf(ssn * (DQK == 64 ? (1.0f / 64) : (1.0f / 128)) + EPS), rsr = 1.0f / sqrtf(ssr * (1.0f / 64) + EPS);
#pragma unroll
        for (int d0 = 0; d0 < ND; ++d0) { float g[8]; load8f(gq + d0 * 16 + hi * 8, g); const float rs = (DQK == 192 && d0 >= 8) ? rsr : rsn;
#pragma unroll
            for (int j = 0; j < 8; ++j) qf[d0][j] = qf[d0][j] * rs * g[j]; }
        if (DQK == 64) {
            float cs[8], sn[8]; load8f(ropec + pos * 8, cs); load8f(ropes + pos * 8, sn);
#pragma unroll
            for (int j = 0; j < 8; ++j) { auto rr = __builtin_amdgcn_permlane32_swap(__float_as_uint(qf[0][j]), __float_as_uint(qf[0][j]), false, false);
                const float other = __uint_as_float(hi ? rr[0] : rr[1]);
                qf[0][j] = hi ? qf[0][j] * cs[j] + other * sn[j] : qf[0][j] * cs[j] - other * sn[j]; }
        }
        if (DQK == 192) {
#pragma unroll
            for (int dd = 0; dd < 2; ++dd) { float cs[8], sn[8]; load8f(ropec + pos * 32 + dd * 16 + hi * 8, cs); load8f(ropes + pos * 32 + dd * 16 + hi * 8, sn);
#pragma unroll
                for (int j = 0; j < 8; ++j) { const float x1 = qf[(DQK == 192 ? 8 : 0) + dd][j], x2 = qf[(DQK == 192 ? 10 : 0) + dd][j];
                    qf[(DQK == 192 ? 8 : 0) + dd][j] = x1 * cs[j] - x2 * sn[j]; qf[(DQK == 192 ? 10 : 0) + dd][j] = x2 * cs[j] + x1 * sn[j]; } }
        }
#pragma unroll
        for (int d0 = 0; d0 < ND; ++d0) qr[d0] = __builtin_bit_cast(bf16x8, pack8(qf[d0]));
      }
#pragma unroll
      for (int d0 = 0; d0 < ND; ++d0) asm volatile("" : "+v"(qr[d0])); }
    unsigned goffK[NKC], goffV[2];
#pragma unroll
    for (int i = 0; i < NKC; ++i) { const int ob = (i * 8 + wid) * 1024 + lane * 16, row = ob / RB, cbs = ob - row * RB, cb = cbs ^ ((row & 7) << 4); goffK[i] = (unsigned)(row * ldk + (cb >> 1)); }
#pragma unroll
    for (int i = 0; i < 2; ++i) { const int ob = (i * 8 + wid) * 1024 + lane * 16, st = ob >> 9, w = (ob & 511) >> 1, kk = ((st >> 2) << 3) | (w >> 5);
        const int k = (kk & ~0xC) | ((kk & 4) << 1) | ((kk & 8) >> 1), c = (st & 3) * 32 + (w & 31); goffV[i] = (unsigned)(k * ldv + c); }
    const int vb0 = (int)(size_t)(lds) + v_rd_base(lane);
#define AT_DMA(t, kslot, vslot) do { const bf16_t* kp_ = Kb + (size_t)((t) * 64) * ldk; const bf16_t* vp_ = Vb + (size_t)((t) * 64) * ldv; \
        _Pragma("unroll") for (int i_ = 0; i_ < NKC; ++i_) __builtin_amdgcn_global_load_lds((const unsigned*)(kp_ + goffK[i_]), (LAS unsigned*)(lds + KOFF + (kslot) * SHK + (i_ * 8 + wid) * 1024), 16, 0, 0); \
        _Pragma("unroll") for (int i_ = 0; i_ < 2; ++i_) __builtin_amdgcn_global_load_lds((const unsigned*)(vp_ + goffV[i_]), (LAS unsigned*)(lds + (vslot) * SHV + (i_ * 8 + wid) * 1024), 16, 0, 0); } while (0)
#define AT_PV(vb_) do { __builtin_amdgcn_s_setprio(1); pv_one<0>(o[0], (vb_), pa0, pa1, pa2, pa3); pv_one<1>(o[1], (vb_), pa0, pa1, pa2, pa3); pv_one<2>(o[2], (vb_), pa0, pa1, pa2, pa3); pv_one<3>(o[3], (vb_), pa0, pa1, pa2, pa3); __builtin_amdgcn_s_setprio(0); } while (0)
    AT_DMA(blk_lo, 0, 0);
    if (blk_lo + 1 <= blk_hi) AT_DMA(blk_lo + 1, 1, 1);
    constexpr bool PIPE = (DQK == 64) && !BIAS;
    if constexpr (PIPE) {
        f32x16 pA0, pA1, pB0, pB1;
        bf16x8 pa0, pa1, pa2, pa3;
        int ksn = 0;
#define PQK(P0, P1, kslot_) do { __builtin_amdgcn_s_setprio(1); _Pragma("unroll") for (int r_ = 0; r_ < 16; ++r_) { P0[r_] = 0.f; P1[r_] = 0.f; } \
            const LAS unsigned char* Ks_ = lds + KOFF + (kslot_) * SHK; \
            _Pragma("unroll") for (int d0_ = 0; d0_ < ND; ++d0_) { const int cb_ = (d0_ * 16 + hi * 8) * 2; \
                const bf16x8 b0_ = *(const LAS bf16x8*)(Ks_ + kswz<DQK>(r32, cb_)); const bf16x8 b1_ = *(const LAS bf16x8*)(Ks_ + kswz<DQK>(32 + r32, cb_)); \
                P0 = __builtin_amdgcn_mfma_f32_32x32x16_bf16(b0_, qr[d0_], P0, 0, 0, 0); P1 = __builtin_amdgcn_mfma_f32_32x32x16_bf16(b1_, qr[d0_], P1, 0, 0, 0); } __builtin_amdgcn_s_setprio(0); } while (0)
#define PK4(P, BASE, OUT) do { unsigned a0 = pk2(P[BASE + 0], P[BASE + 1]), a1 = pk2(P[BASE + 2], P[BASE + 3]);   \
    unsigned b0 = pk2(P[BASE + 4], P[BASE + 5]), b1 = pk2(P[BASE + 6], P[BASE + 7]);                              \
    auto r0 = __builtin_amdgcn_permlane32_swap(a0, b0, false, false); auto r1 = __builtin_amdgcn_permlane32_swap(a1, b1, false, false); \
    u32x4 w = {r0[0], r1[0], r0[1], r1[1]}; OUT = *reinterpret_cast<bf16x8*>(&w); } while (0)
#define PSMPV(P0, P1, tt_) do { float mx_ = P0[0]; \
            _Pragma("unroll") for (int r_ = 1; r_ < 16; ++r_) mx_ = fmaxf(mx_, P0[r_]); \
            _Pragma("unroll") for (int r_ = 0; r_ < 16; ++r_) mx_ = fmaxf(mx_, P1[r_]); \
            { auto rr_ = __builtin_amdgcn_permlane32_swap(__float_as_uint(mx_), __float_as_uint(mx_), false, false); mx_ = fmaxf(__uint_as_float(rr_[0]), __uint_as_float(rr_[1])); } \
            mx_ *= C; float alpha_ = 1.f; const bool keep_ = __all(mx_ - m_reg <= THR_L2); \
            if (!keep_) { const float mn_ = fmaxf(m_reg, mx_); alpha_ = __builtin_amdgcn_exp2f(m_reg - mn_); m_reg = mn_; } \
            { const float nm_ = -m_reg; _Pragma("unroll") for (int r_ = 0; r_ < 16; ++r_) { P0[r_] = __builtin_amdgcn_exp2f(fmaf(P0[r_], C, nm_)); P1[r_] = __builtin_amdgcn_exp2f(fmaf(P1[r_], C, nm_)); } } \
            float ps_ = 0.f; _Pragma("unroll") for (int r_ = 0; r_ < 16; ++r_) ps_ += P0[r_]; _Pragma("unroll") for (int r_ = 0; r_ < 16; ++r_) ps_ += P1[r_]; \
            { auto rr_ = __builtin_amdgcn_permlane32_swap(__float_as_uint(ps_), __float_as_uint(ps_), false, false); ps_ = __uint_as_float(rr_[0]) + __uint_as_float(rr_[1]); } \
            l_reg = l_reg * alpha_ + ps_; \
            PK4(P0, 0, pa0); PK4(P0, 8, pa1); PK4(P1, 0, pa2); PK4(P1, 8, pa3); \
            if (!keep_) { if (hi == 0) al_l[r32] = alpha_; asm volatile("s_waitcnt lgkmcnt(0)" ::: "memory"); \
                _Pragma("unroll") for (int r_ = 0; r_ < 16; ++r_) { const float a_ = al_l[crow(r_, hi)]; _Pragma("unroll") for (int d_ = 0; d_ < 4; ++d_) o[d_][r_] *= a_; } } \
            const int vb_ = vb0 + (((tt_) - blk_lo) & 3) * SHV; AT_PV(vb_); } while (0)
#define PSTEP(tt_, PC0, PC1, PN0, PN1) do { \
            if ((tt_) + 2 <= blk_hi) asm volatile("s_waitcnt vmcnt(3) lgkmcnt(0)" ::: "memory"); else asm volatile("s_waitcnt vmcnt(0) lgkmcnt(0)" ::: "memory"); \
            __builtin_amdgcn_s_barrier(); asm volatile("" ::: "memory"); \
            if ((tt_) + 3 <= blk_hi) { const int s3_ = (ksn >= 1) ? ksn - 1 : 2; AT_DMA((tt_) + 3, s3_, ((tt_) + 3 - blk_lo) & 3); } \
            if ((tt_) + 1 >= w_lo && (tt_) + 1 <= w_hi) PQK(PN0, PN1, ksn); \
            if ((tt_) >= w_lo && (tt_) <= w_hi) PSMPV(PC0, PC1, (tt_)); \
            ksn = (ksn == 2) ? 0 : ksn + 1; } while (0)
        for (int t = blk_lo - 1; t <= blk_hi; t += 2) {
            PSTEP(t, pA0, pA1, pB0, pB1);
            if (t + 1 <= blk_hi) PSTEP(t + 1, pB0, pB1, pA0, pA1);
        }
#undef PSTEP
#undef PSMPV
#undef PK4
#undef PQK
    } else {
    int slot = 0;
    bf16x8 pa0, pa1, pa2, pa3;
    bool pend = false; int pend_vb = 0;
    for (int t = blk_lo; t <= blk_hi; ++t) {
        if (t + 1 <= blk_hi) { if constexpr (NKC == 1) asm volatile("s_waitcnt vmcnt(3) lgkmcnt(0)" ::: "memory"); else if constexpr (NKC == 2) asm volatile("s_waitcnt vmcnt(4) lgkmcnt(0)" ::: "memory"); else asm volatile("s_waitcnt vmcnt(5) lgkmcnt(0)" ::: "memory"); }
        else asm volatile("s_waitcnt vmcnt(0) lgkmcnt(0)" ::: "memory");
        __builtin_amdgcn_s_barrier();
        asm volatile("" ::: "memory");
        if (t + 2 <= blk_hi) { const int s2 = (slot >= 1) ? slot - 1 : 2; AT_DMA(t + 2, s2, (t + 2 - blk_lo) & 3); }
        if (pend) { AT_PV(pend_vb); pend = false; }
        if (t >= w_lo && t <= w_hi) {
            f32x16 p0, p1;
#pragma unroll
            for (int r = 0; r < 16; ++r) { p0[r] = 0.f; p1[r] = 0.f; }
            const LAS unsigned char* Ks = lds + KOFF + slot * SHK;
            __builtin_amdgcn_s_setprio(1);
#pragma unroll
            for (int d0 = 0; d0 < ND; ++d0) { const int cb = (d0 * 16 + hi * 8) * 2;
                const bf16x8 b0 = *(const LAS bf16x8*)(Ks + kswz<DQK>(r32, cb));
                const bf16x8 b1 = *(const LAS bf16x8*)(Ks + kswz<DQK>(32 + r32, cb));
                p0 = __builtin_amdgcn_mfma_f32_32x32x16_bf16(b0, qr[d0], p0, 0, 0, 0);
                p1 = __builtin_amdgcn_mfma_f32_32x32x16_bf16(b1, qr[d0], p1, 0, 0, 0); }
            __builtin_amdgcn_s_setprio(0);
            float mx;
            if (BIAS) {
                const int dch = cw - t;
                if (dch >= 3) { const float bc = bias_l[191];
#pragma unroll
                    for (int r = 0; r < 16; ++r) { p0[r] = fmaf(p0[r], C, bc); p1[r] = fmaf(p1[r], C, bc); }
                } else { const int base = dch * 64 + (wid & 1) * 32 + r32 + 63;
#pragma unroll
                    for (int r = 0; r < 16; ++r) { const int kk = crow(r, hi); const int i0 = base - kk, i1 = base - kk - 32;
                        p0[r] = fmaf(p0[r], C, bias_l[i0 > 191 ? 191 : i0]); p1[r] = fmaf(p1[r], C, bias_l[i1 > 191 ? 191 : i1]); }
                }
            }
            mx = p0[0];
#pragma unroll
            for (int r = 1; r < 16; ++r) mx = fmaxf(mx, p0[r]);
#pragma unroll
            for (int r = 0; r < 16; ++r) mx = fmaxf(mx, p1[r]);
            { auto rr = __builtin_amdgcn_permlane32_swap(__float_as_uint(mx), __float_as_uint(mx), false, false);
              mx = fmaxf(__uint_as_float(rr[0]), __uint_as_float(rr[1])); }
            if (!BIAS) mx *= C;
            float alpha = 1.f;
            const bool keep = __all(mx - m_reg <= THR_L2);
            if (!keep) { const float mn = fmaxf(m_reg, mx); alpha = __builtin_amdgcn_exp2f(m_reg - mn); m_reg = mn; }
            if (BIAS) {
#pragma unroll
                for (int r = 0; r < 16; ++r) { p0[r] = __builtin_amdgcn_exp2f(p0[r] - m_reg); p1[r] = __builtin_amdgcn_exp2f(p1[r] - m_reg); }
            } else { const float nm = -m_reg;
#pragma unroll
                for (int r = 0; r < 16; ++r) { p0[r] = __builtin_amdgcn_exp2f(fmaf(p0[r], C, nm)); p1[r] = __builtin_amdgcn_exp2f(fmaf(p1[r], C, nm)); }
            }
            float ps = 0.f;
#pragma unroll
            for (int r = 0; r < 16; ++r) ps += p0[r];
#pragma unroll
            for (int r = 0; r < 16; ++r) ps += p1[r];
            { auto rr = __builtin_amdgcn_permlane32_swap(__float_as_uint(ps), __float_as_uint(ps), false, false);
              ps = __uint_as_float(rr[0]) + __uint_as_float(rr[1]); }
            l_reg = l_reg * alpha + ps;
#define PK4(P, BASE, OUT) do { unsigned a0 = pk2(P[BASE + 0], P[BASE + 1]), a1 = pk2(P[BASE + 2], P[BASE + 3]);   \
    unsigned b0 = pk2(P[BASE + 4], P[BASE + 5]), b1 = pk2(P[BASE + 6], P[BASE + 7]);                              \
    auto r0 = __builtin_amdgcn_permlane32_swap(a0, b0, false, false); auto r1 = __builtin_amdgcn_permlane32_swap(a1, b1, false, false); \
    u32x4 w = {r0[0], r1[0], r0[1], r1[1]}; OUT = *reinterpret_cast<bf16x8*>(&w); } while (0)
            PK4(p0, 0, pa0); PK4(p0, 8, pa1); PK4(p1, 0, pa2); PK4(p1, 8, pa3);
#undef PK4
            if (!keep) {
                if (hi == 0) al_l[r32] = alpha;
                asm volatile("s_waitcnt lgkmcnt(0)" ::: "memory");
#pragma unroll
                for (int r = 0; r < 16; ++r) { const float a = al_l[crow(r, hi)];
#pragma unroll
                    for (int d = 0; d < 4; ++d) o[d][r] *= a; }
            }
            const int vb = vb0 + ((t - blk_lo) & 3) * SHV;
            if (late) { pend = true; pend_vb = vb; }
            else AT_PV(vb);
        }
        slot = (slot == 2) ? 0 : slot + 1;
    }
    if (pend) AT_PV(pend_vb);
    }
#undef AT_DMA
#undef AT_PV
    if (hi == 0) li_l[r32] = l_reg;
    asm volatile("s_waitcnt lgkmcnt(0)" ::: "memory");
    float rli[16];
#pragma unroll
    for (int r = 0; r < 16; ++r) rli[r] = __builtin_amdgcn_rcpf(li_l[crow(r, hi)]);
    bf16_t* Ow = Ob + (size_t)(wid * 32) * ldo;
    if (epi == 0) {
#pragma unroll
        for (int r = 0; r < 16; ++r) { const int orow = crow(r, hi);
#pragma unroll
            for (int d0 = 0; d0 < 4; ++d0) Ow[(size_t)orow * ldo + d0 * 32 + r32] = f2bf(o[d0][r] * rli[r]); }
    } else if (epi == 1) {
        const bf16_t* Zw = Zb + (size_t)(wid * 32) * NU;
        bf16_t zr[16][4];
#pragma unroll
        for (int r = 0; r < 16; ++r) { const int orow = crow(r, hi);
#pragma unroll
            for (int d0 = 0; d0 < 4; ++d0) zr[r][d0] = Zw[(size_t)orow * NU + d0 * 32 + r32]; }
#pragma unroll
        for (int r = 0; r < 16; ++r) { const int orow = crow(r, hi);
#pragma unroll
            for (int d0 = 0; d0 < 4; ++d0) { const float z = __uint_as_float((unsigned)zr[r][d0] << 16);
                Ow[(size_t)orow * ldo + d0 * 32 + r32] = f2bf(o[d0][r] * rli[r] * z); } }
    } else {
        const bf16_t* Zw = Zb + (size_t)(wid * 32) * NU; const bf16_t* O0w = O0b + (size_t)(wid * 32) * ldo;
        float gs[4];
#pragma unroll
        for (int d0 = 0; d0 < 4; ++d0) gs[d0] = gsub[d0 * 32 + r32] * post;
        bf16_t zr[16][4], o0r[16][4];
#pragma unroll
        for (int r = 0; r < 16; ++r) { const int orow = crow(r, hi);
#pragma unroll
            for (int d0 = 0; d0 < 4; ++d0) { zr[r][d0] = Zw[(size_t)orow * NU + d0 * 32 + r32]; o0r[r][d0] = O0w[(size_t)orow * ldo + d0 * 32 + r32]; } }
#pragma unroll
        for (int r = 0; r < 16; ++r) { const int orow = crow(r, hi); float d[4]; float ss = 0.f;
#pragma unroll
            for (int d0 = 0; d0 < 4; ++d0) { const float o0 = __uint_as_float((unsigned)o0r[r][d0] << 16);
                d[d0] = o0 - lam * (o[d0][r] * rli[r]); ss += d[d0] * d[d0]; }
            ss = xsum(ss, 1, 16);
            const float rs = 1.0f / sqrtf(ss * (1.0f / 128) + EPS);
#pragma unroll
            for (int d0 = 0; d0 < 4; ++d0) { const float z = __uint_as_float((unsigned)zr[r][d0] << 16);
                Ow[(size_t)orow * ldo + d0 * 32 + r32] = f2bf(d[d0] * rs * gs[d0] * z); } }
    }
    __syncthreads();
}

#define XB_TMO      128
#define XB_XCNT(j)  (256  + 64 * (j))
#define XB_XSUB(j)  (1280 + 64 * (j))
#define XB_XGEN(j)  (2304 + 64 * (j))
#define XB_TOP      3328
#define XB_TOPGEN   3392
#define XCD_BAR_WORDS 3456
#define XB_SPIN_CAP (1u << 20)
DI unsigned xb_ld(unsigned* p)              { return __hip_atomic_load(p, __ATOMIC_RELAXED, __HIP_MEMORY_SCOPE_AGENT); }
DI unsigned xb_add(unsigned* p, unsigned v) { return __hip_atomic_fetch_add(p, v, __ATOMIC_RELAXED, __HIP_MEMORY_SCOPE_AGENT); }
DI unsigned xb_xcc_id() { return (unsigned)__builtin_amdgcn_s_getreg((3 << 11) | 20) & 0xFu; }
#define XB_SPIN(cond, bar) do { unsigned _sp = 0; while (cond) { __builtin_amdgcn_s_sleep(1); \
    if ((++_sp & 255u) == 0u) { if (xb_ld(&(bar)[XB_TMO])) break; if (_sp > XB_SPIN_CAP) { atomicAdd(&(bar)[XB_TMO], 1u); break; } } } } while (0)
struct XcdBarrier { unsigned* bar; unsigned x; volatile LAS unsigned* st; };
DI XcdBarrier xcd_barrier_post(unsigned* bar, volatile LAS unsigned* st) {
    XcdBarrier b; b.bar = bar; b.x = xb_xcc_id(); b.st = st;
    if (threadIdx.x == 0) (void)xb_add(&bar[XB_XCNT(b.x)], 1u);
    return b;
}
DI void xcd_barrier_complete(unsigned* bar, unsigned x, unsigned& nloc, unsigned& nx) {
    const unsigned G = gridDim.x * gridDim.y * gridDim.z;
    unsigned sum, cnt, mine, sp = 0u;
    for (;;) {
        sum = 0u; cnt = 0u; mine = 0u;
#pragma unroll
        for (unsigned j = 0; j < 16; ++j) { const unsigned c = xb_ld(&bar[XB_XCNT(j)]); sum += c; cnt += (c > 0u) ? 1u : 0u; mine = (j == x) ? c : mine; }
        if (sum == G) break;
        __builtin_amdgcn_s_sleep(1);
        if ((++sp & 255u) == 0u) { if (xb_ld(&bar[XB_TMO])) break; if (sp > XB_SPIN_CAP) { atomicAdd(&bar[XB_TMO], 1u); break; } }
    }
    nloc = mine > 0u ? mine : 1u; nx = cnt > 0u ? cnt : 1u;
}
DI void xcd_barrier(const XcdBarrier& b) {
    asm volatile("s_waitcnt vmcnt(0)" ::: "memory");
    __syncthreads();
    if (threadIdx.x == 0) {
        unsigned* bar = b.bar;
        __builtin_amdgcn_s_waitcnt(0);
        unsigned nloc = b.st[0], nx = b.st[1];
        if (nloc == 0u) { xcd_barrier_complete(bar, b.x, nloc, nx); b.st[0] = nloc; b.st[1] = nx; }
        const unsigned old = xb_add(&bar[XB_XSUB(b.x)], 1u);
        const unsigned gen = old / nloc;
        if (old + 1u == (gen + 1u) * nloc) {
            __builtin_amdgcn_fence(__ATOMIC_RELEASE, "agent");
            asm volatile("s_waitcnt vmcnt(0)" ::: "memory");
            const unsigned og = xb_add(&bar[XB_TOP], 1u);
            const unsigned tg = og / nx;
            if (og + 1u == (tg + 1u) * nx) xb_add(&bar[XB_TOPGEN], 1u);
            else XB_SPIN(xb_ld(&bar[XB_TOPGEN]) == tg, bar);
            __builtin_amdgcn_fence(__ATOMIC_ACQUIRE, "agent");
            xb_add(&bar[XB_XGEN(b.x)], 1u);
            asm volatile("s_waitcnt vmcnt(0)" ::: "memory");
        } else {
            XB_SPIN(xb_ld(&bar[XB_XGEN(b.x)]) == gen, bar);
            __builtin_amdgcn_fence(__ATOMIC_ACQUIRE, "agent");
            asm volatile("s_waitcnt vmcnt(0)" ::: "memory");
        }
    }
    __syncthreads();
}

struct Args {
    const float* in[18];
    float* out; unsigned char* ws;
};

DI void transpose_item(const float* __restrict__ W, int K, int N, bf16_t* __restrict__ WT, int ldw, int koff, bool remap, LAS float* scr, int item, int lane) {
    const int nblk = N / 32, kb = item / nblk, nb = item - kb * nblk, k0 = 64 * kb, n0 = 32 * nb;
    float v[32];
    const float* src = W + (size_t)(k0 + (lane >> 5)) * N + n0 + (lane & 31);
#pragma unroll
    for (int i = 0; i < 32; ++i) v[i] = src[(size_t)(2 * i) * N];
#pragma unroll
    for (int i = 0; i < 32; ++i) scr[(2 * i + (lane >> 5)) * 33 + (lane & 31)] = v[i];
    asm volatile("s_waitcnt lgkmcnt(0)" ::: "memory");
    int d0 = n0; if (remap && n0 >= 832) d0 += 192;
    const int c = lane & 7;
#pragma unroll
    for (int j = 0; j < 4; ++j) { const int n = (lane >> 3) + 8 * j; const LAS float* s = scr + (8 * c) * 33 + n;
        u32x4 o; o.x = pk2(s[0 * 33], s[1 * 33]); o.y = pk2(s[2 * 33], s[3 * 33]); o.z = pk2(s[4 * 33], s[5 * 33]); o.w = pk2(s[6 * 33], s[7 * 33]);
        *(u32x4*)(WT + (size_t)(d0 + n) * ldw + koff + k0 + 8 * c) = o; }
    asm volatile("s_waitcnt lgkmcnt(0)" ::: "memory");
}

typedef const __attribute__((address_space(4))) Args* ArgsP;
DI ArgsP get_args() { ArgsP ap = (ArgsP)__builtin_amdgcn_kernarg_segment_ptr(); asm volatile("" : "+s"(ap)); return ap; }

DI void phase_prep(const int l, LAS unsigned char* lds) {
    ArgsP ap = get_args();
    int tid_ = threadIdx.x; asm volatile("" : "+v"(tid_));
    const int tid = tid_, lane = tid & 63, wid = __builtin_amdgcn_readfirstlane(tid >> 6);
    const int G = gridDim.x, gw = blockIdx.x * 8 + wid, NGW = G * 8;
    unsigned char* ws = ap->ws;
    bf16_t* WIN = (bf16_t*)(ws + WS_WIN);
    if (l == 0) {
        float* ropeT = (float*)(ws + WS_ROPE);
        for (int idx = blockIdx.x * 512 + tid; idx < SEQ * 40; idx += G * 512) {
            const int pos = idx / 40, k = idx - pos * 40;
            float inv; if (k < 32) inv = 1.0f / powf(10000.0f, (float)(2 * k) / 64.0f); else inv = 1.0f / powf(500000.0f, (float)(2 * (k - 32)) / 16.0f);
            const float ang = (float)pos * inv;
            double rev = (double)ang * 0.15915494309189535; rev -= floor(rev);
            const float fr = (float)rev; const float cs = __builtin_amdgcn_cosf(fr), sn = __builtin_amdgcn_sinf(fr);
            if (k < 32) { ropeT[pos * 32 + k] = cs; ropeT[SEQ * 32 + pos * 32 + k] = sn; }
            else { ropeT[SEQ * 64 + pos * 8 + (k - 32)] = cs; ropeT[SEQ * 72 + pos * 8 + (k - 32)] = sn; }
        }
    }
    for (int i = blockIdx.x * 512 + tid; i < 192 * DM / 8; i += G * 512) *(u32x4*)(WIN + (size_t)832 * DM + (size_t)i * 8) = (u32x4){0u, 0u, 0u, 0u};
    {
        const float* w_in = ap->in[2] + (size_t)l * DM * DIN;
        const float* a_w_uq = ap->in[5] + (size_t)l * 512 * 1536; const float* a_w_ukv = ap->in[6] + (size_t)l * 256 * 2048;
        const float* w_branch = ap->in[16] + (size_t)l * 3 * 1024 * 2048; const float* w_out = ap->in[17] + (size_t)l * DM * DM;
        bf16_t* WUQ = (bf16_t*)(ws + WS_WUQ); bf16_t* WUKV = (bf16_t*)(ws + WS_WUKV); bf16_t* WB = (bf16_t*)(ws + WS_WB); bf16_t* WO = (bf16_t*)(ws + WS_WO);
        LAS float* scr = (LAS float*)(lds) + wid * (64 * 33);
        constexpr int I_IN = (DM / 64) * (DIN / 32), I_UQ = (512 / 64) * (1536 / 32), I_UKV = (256 / 64) * (2048 / 32), I_BR = (1024 / 64) * (2048 / 32), I_OUT = (DM / 64) * (DM / 32);
        constexpr int NITEMS = I_IN + I_UQ + I_UKV + 3 * I_BR + I_OUT;
        for (int it = gw; it < NITEMS; it += NGW) {
            int r = it;
            if (r < I_IN) { transpose_item(w_in, DM, DIN, WIN, DM, 0, true, scr, r, lane); continue; } r -= I_IN;
            if (r < I_UQ) { transpose_item(a_w_uq, 512, 1536, WUQ, 512, 0, false, scr, r, lane); continue; } r -= I_UQ;
            if (r < I_UKV) { transpose_item(a_w_ukv, 256, 2048, WUKV, 256, 0, false, scr, r, lane); continue; } r -= I_UKV;
            if (r < 3 * I_BR) { const int n = r / I_BR; transpose_item(w_branch + (size_t)n * 1024 * 2048, 1024, 2048, WB, 3072, n * 1024, false, scr, r - n * I_BR, lane); continue; } r -= 3 * I_BR;
            transpose_item(w_out, DM, DM, WO, DM, 0, false, scr, r, lane);
        }
    }
    {
        const float* xin = (l == 0) ? ap->in[0] : ap->out; const float* g_pre = ap->in[1] + (size_t)l * DM; bf16_t* H = (bf16_t*)(ws + WS_R1);
        for (int t = gw; t < T; t += NGW) {
            const float* xr = xin + (size_t)t * DM; f32x4 v[8]; float ss = 0.f;
#pragma unroll
            for (int j = 0; j < 8; ++j) { v[j] = *(const f32x4*)(xr + j * 256 + lane * 4); ss += (v[j].x * v[j].x + v[j].y * v[j].y) + (v[j].z * v[j].z + v[j].w * v[j].w); }
            ss = xsum(ss, 1, 32);
            const float rs = 1.0f / sqrtf(ss * (1.0f / DM) + EPS);
#pragma unroll
            for (int j = 0; j < 8; ++j) { const f32x4 g = *(const f32x4*)(g_pre + j * 256 + lane * 4);
                uint2 o; o.x = pk2(v[j].x * rs * g.x, v[j].y * rs * g.y); o.y = pk2(v[j].z * rs * g.z, v[j].w * rs * g.w);
                *(uint2*)(H + (size_t)t * DM + j * 256 + lane * 4) = o; }
        }
    }
}

DI void phase_post_u(const int l) {
    ArgsP ap = get_args();
    int tid_ = threadIdx.x; asm volatile("" : "+v"(tid_));
    const int tid = tid_, lane = tid & 63, wid = __builtin_amdgcn_readfirstlane(tid >> 6);
    const int gw = blockIdx.x * 8 + wid, NGW = gridDim.x * 8;
    unsigned char* ws = ap->ws;
    const float* ropeT = (const float*)(ws + WS_ROPE);
    const float* cosA = ropeT; const float* sinA = ropeT + SEQ * 32; const float* cosB = ropeT + SEQ * 64; const float* sinB = ropeT + SEQ * 72;
    bf16_t* U = (bf16_t*)(ws + WS_U); bf16_t* KA = (bf16_t*)(ws + WS_KA);
    const bool is_kr = (lane >= 32 && lane < 40);
    float g_cq[8], g_kv[8], g_bq[8], g_bk[8], g_cq2[8], g_ck[8];
    load8f(ap->in[3] + l * 512 + lane * 8, g_cq);
    load8f(is_kr ? ap->in[8] + l * 192 + 128 + (lane - 32) * 8 : ap->in[4] + l * 256 + (lane & 31) * 8, g_kv);
    load8f(ap->in[9] + l * 64 + (lane & 7) * 8, g_bq); load8f(ap->in[10] + l * 64 + (lane & 7) * 8, g_bk);
    load8f(ap->in[13] + l * 128 + (lane & 15) * 8, g_cq2); load8f(ap->in[14] + l * 128 + (lane & 15) * 8, g_ck);
    const int iA = (lane & 3) * 8, l7 = lane & 7;
    for (int t = gw; t < T; t += NGW) {
        bf16_t* ur = U + (size_t)t * NU; const int pos = t & (SEQ - 1);
        u32x4 raw[10];
        raw[0] = *(const u32x4*)(ur + UC_CQ + lane * 8); raw[1] = *(const u32x4*)(ur + UC_CKV + lane * 8);
#pragma unroll
        for (int hf = 0; hf < 2; ++hf) { raw[4 + hf] = *(const u32x4*)(ur + UC_BK + hf * 512 + lane * 8); raw[8 + hf] = *(const u32x4*)(ur + UC_CK + hf * 512 + lane * 8); }
        float csA[8], snA[8], csB[8], snB[8];
        load8f(cosA + pos * 32 + iA, csA); load8f(sinA + pos * 32 + iA, snA); load8f(cosB + pos * 8, csB); load8f(sinB + pos * 8, snB);
        float f[8];
        {
            unpack8(raw[0], f);
            const float rs = 1.0f / sqrtf(xsum(sumsq8(f), 1, 32) * (1.0f / 512) + EPS);
#pragma unroll
            for (int j = 0; j < 8; ++j) f[j] = f[j] * rs * g_cq[j];
            *(u32x4*)(ur + UC_CQ + lane * 8) = pack8(f);
        }
        {
            unpack8(raw[1], f);
            const float s8 = xsum(sumsq8(f), 1, 4), s32 = xsum(s8, 8, 16);
            const float rs = is_kr ? 1.0f / sqrtf(s8 * (1.0f / 64) + EPS) : 1.0f / sqrtf(s32 * (1.0f / 256) + EPS);
#pragma unroll
            for (int j = 0; j < 8; ++j) f[j] = f[j] * rs * g_kv[j];
            float yp[8];
#pragma unroll
            for (int j = 0; j < 8; ++j) yp[j] = __shfl_xor(f[j], 4);
            if (lane < 32) *(u32x4*)(ur + UC_CKV + lane * 8) = pack8(f);
            if (is_kr) {
                const bool first = (lane < 36); float o[8];
#pragma unroll
                for (int j = 0; j < 8; ++j) o[j] = first ? f[j] * csA[j] - yp[j] * snA[j] : f[j] * csA[j] + yp[j] * snA[j];
                const u32x4 pk = pack8(o);
#pragma unroll
                for (int h = 0; h < 8; ++h) *(u32x4*)(KA + (size_t)t * 1536 + h * 192 + 128 + (lane - 32) * 8) = pk;
            }
        }
#pragma unroll
        for (int w = 1; w < 2; ++w) {
#pragma unroll
            for (int hf = 0; hf < 2; ++hf) { bf16_t* p = ur + (w ? UC_BK : UC_BQ) + hf * 512 + lane * 8;
                unpack8(raw[2 + 2 * w + hf], f);
                const float rs = 1.0f / sqrtf(xsum(sumsq8(f), 1, 4) * (1.0f / 64) + EPS);
#pragma unroll
                for (int j = 0; j < 8; ++j) f[j] = f[j] * rs * (w ? g_bk[j] : g_bq[j]);
                float yp[8];
#pragma unroll
                for (int j = 0; j < 8; ++j) yp[j] = __shfl_xor(f[j], 1);
                if (l7 < 2) {
#pragma unroll
                    for (int j = 0; j < 8; ++j) f[j] = (l7 == 0) ? f[j] * csB[j] - yp[j] * snB[j] : f[j] * csB[j] + yp[j] * snB[j]; }
                *(u32x4*)p = pack8(f); } }
#pragma unroll
        for (int w = 1; w < 2; ++w) {
#pragma unroll
            for (int hf = 0; hf < 2; ++hf) { bf16_t* p = ur + (w ? UC_CK : UC_CQ2) + hf * 512 + lane * 8;
                unpack8(raw[6 + 2 * w + hf], f);
                const float rs = 1.0f / sqrtf(xsum(sumsq8(f), 1, 8) * (1.0f / 128) + EPS);
#pragma unroll
                for (int j = 0; j < 8; ++j) f[j] = f[j] * rs * (w ? g_ck[j] : g_cq2[j]);
                *(u32x4*)p = pack8(f); } }
    }
}

DI void phase_post_a(const int l) {
    ArgsP ap = get_args();
    int tid_ = threadIdx.x; asm volatile("" : "+v"(tid_));
    const int tid = tid_, lane = tid & 63, wid = __builtin_amdgcn_readfirstlane(tid >> 6);
    const int gw = blockIdx.x * 8 + wid, NGW = gridDim.x * 8;
    unsigned char* ws = ap->ws;
    const float* ropeT = (const float*)(ws + WS_ROPE);
    const float* cosA = ropeT; const float* sinA = ropeT + SEQ * 32;
    bf16_t* QA = (bf16_t*)(ws + WS_QA); bf16_t* KVA = (bf16_t*)(ws + WS_KVA); bf16_t* KA = (bf16_t*)(ws + WS_KA);
    const int slot = lane & 31, l31 = lane & 31; const bool act = slot < 24, rope = slot >= 16;
    float g_q[8], g_k[8];
    load8f(ap->in[7] + l * 192 + (act ? slot * 8 : 0), g_q); load8f(ap->in[8] + l * 192 + (l31 & 15) * 8, g_k);
    const int iA = (slot & 3) * 8;
    for (int t = gw; t < T; t += NGW) {
        const int pos = t & (SEQ - 1); float f[8];
        u32x4 rq[4], rk[4];
#pragma unroll
        for (int st = 0; st < 4; ++st) { const int head = st * 2 + (lane >> 5);
            rk[st] = *(const u32x4*)(KVA + (size_t)t * 2048 + head * 256 + l31 * 8); }
#pragma unroll
        for (int st = 0; st < 4; ++st) {
            const int head = st * 2 + (lane >> 5);
            unpack8(rk[st], f);
            const float rs = 1.0f / sqrtf(xsum(sumsq8(f), 1, 8) * (1.0f / 128) + EPS);
#pragma unroll
            for (int j = 0; j < 8; ++j) f[j] = f[j] * rs * g_k[j];
            if (l31 < 16) *(u32x4*)(KA + (size_t)t * 1536 + head * 192 + l31 * 8) = pack8(f);
        }
    }
}

DI int q_fetch(unsigned* ctr, LAS unsigned* qw) {
    if (threadIdx.x == 0) *qw = atomicAdd(ctr, 1u);
    __syncthreads();
    return __builtin_amdgcn_readfirstlane((int)*qw);
}
DI void phase_attn(const int l, LAS unsigned char* lds) {
    LAS unsigned* qw = (LAS unsigned*)(lds + ATT_QW);
#if PH(11)
    {
        ArgsP ap = get_args(); unsigned char* ws = ap->ws; unsigned* ctl = (unsigned*)(ws + WS_CTL) + l * 4;
        int tid = threadIdx.x; asm volatile("" : "+v"(tid)); const int wid = __builtin_amdgcn_readfirstlane(tid >> 6), lane = tid & 63;
        const float* b_lam = ap->in[11] + l * 256; const float* gsub = ap->in[12] + l * 128;
        const float lam_init = (l == 0) ? 0.2f : 0.35550906759f;
        float lam;
        { const float a = b_lam[lane] * b_lam[64 + lane], b2 = b_lam[128 + lane] * b_lam[192 + lane];
          lam = expf(xsum(a, 1, 32)) - expf(xsum(b2, 1, 32)) + lam_init; }
        for (;;) {
            const int idx = q_fetch(ctl + 1, qw);
            if (idx >= 512) break;
            const int qblk = 15 - (idx >> 5), r = idx & 31, b = r >> 3, h = r & 7; const size_t tok0 = (size_t)b * SEQ, q0 = tok0 + (size_t)qblk * 256;
            bf16_t* U = (bf16_t*)(ws + WS_U); bf16_t* Gt = (bf16_t*)(ws + WS_G);
            for (int c = 0; c < 2; ++c) {
                const int hc = h * 2 + c;
                bf16_t* outp = Gt + q0 * 3072 + 1024 + h * 128;
                attn_unit<64, false, NU, NU, NU, 3072>(ap->in[9] + l * 64, (const float*)(ws + WS_ROPE) + SEQ * 64, (const float*)(ws + WS_ROPE) + SEQ * 72, qblk * 256,
                                     U + q0 * NU + UC_BQ + hc * 64, U + tok0 * NU + UC_BK + hc * 64, U + tok0 * NU + UC_BV + h * 128,
                                     outp, 0, qblk * 4 + 3, qblk * 4 + (wid >> 1), 0.125f * LOG2E, lds,
                                     c ? 2 : 0, U + q0 * NU + UC_BZ + h * 128, outp, lam, 1.0f - lam_init, gsub);
            }
        }
    }
#endif
#if PH(10)
    {
        ArgsP ap = get_args(); unsigned char* ws = ap->ws; unsigned* ctl = (unsigned*)(ws + WS_CTL) + l * 4;
        int wid = threadIdx.x >> 6; asm volatile("" : "+v"(wid)); wid = __builtin_amdgcn_readfirstlane(wid);
        for (;;) {
            const int idx = q_fetch(ctl + 0, qw);
            if (idx >= 512) break;
            const int qblk = 15 - (idx >> 5), r = idx & 31, b = r >> 3, h = r & 7; const size_t tok0 = (size_t)b * SEQ, q0 = tok0 + (size_t)qblk * 256;
            bf16_t* QA = (bf16_t*)(ws + WS_QA); bf16_t* KVA = (bf16_t*)(ws + WS_KVA); bf16_t* KA = (bf16_t*)(ws + WS_KA); bf16_t* Gt = (bf16_t*)(ws + WS_G);
            const bf16_t* U = (const bf16_t*)(ws + WS_U);
            attn_unit<192, false, 1536, 1536, 2048, 3072>(ap->in[7] + l * 192, (const float*)(ws + WS_ROPE), (const float*)(ws + WS_ROPE) + SEQ * 32, qblk * 256,
                                  QA + q0 * 1536 + h * 192, KA + tok0 * 1536 + h * 192, KVA + tok0 * 2048 + h * 256 + 128,
                                  Gt + q0 * 3072 + h * 128, 0, qblk * 4 + 3, qblk * 4 + (wid >> 1), 0.07216878364870322f * LOG2E, lds,
                                  1, U + q0 * NU + UC_AZ + h * 128, nullptr, 0.f, 0.f, nullptr);
        }
    }
#endif
#if PH(12)
    {
        ArgsP ap = get_args(); unsigned char* ws = ap->ws; unsigned* ctl = (unsigned*)(ws + WS_CTL) + l * 4;
        const float* c_rel = ap->in[15] + l * 8 * 192;
        int wid = threadIdx.x >> 6; asm volatile("" : "+v"(wid)); wid = __builtin_amdgcn_readfirstlane(wid);
        for (;;) {
            const int idx = q_fetch(ctl + 2, qw);
            if (idx >= 512) break;
            const int qblk = 15 - (idx >> 5), r = idx & 31, b = r >> 3, h = r & 7; const size_t tok0 = (size_t)b * SEQ, q0 = tok0 + (size_t)qblk * 256;
            bf16_t* U = (bf16_t*)(ws + WS_U); bf16_t* Gt = (bf16_t*)(ws + WS_G);
            if (threadIdx.x < 192) ((LAS float*)(lds + ATT_BIAS))[threadIdx.x] = c_rel[h * 192 + threadIdx.x] * LOG2E;
            const int lo = qblk * 4 - 8;
            attn_unit<128, true, NU, NU, NU, 3072>(ap->in[13] + l * 128, nullptr, nullptr, qblk * 256,
                                 U + q0 * NU + UC_CQ2 + h * 128, U + tok0 * NU + UC_CK + h * 128, U + tok0 * NU + UC_CV + h * 128,
                                 Gt + q0 * 3072 + 2048 + h * 128, lo > 0 ? lo : 0, qblk * 4 + 3, qblk * 4 + (wid >> 1), 0.08838834764831845f * LOG2E, lds,
                                 1, U + q0 * NU + UC_CZ + h * 128, nullptr, 0.f, 0.f, nullptr);
        }
    }
#endif
}

DI void phase_gate(const int l) {
    ArgsP ap = get_args();
    int tid_ = threadIdx.x; asm volatile("" : "+v"(tid_));
    const int tid = tid_, lane = tid & 63, wid = __builtin_amdgcn_readfirstlane(tid >> 6);
    const int gw = blockIdx.x * 8 + wid, NGW = gridDim.x * 8;
    unsigned char* ws = ap->ws;
    const bf16_t* U = (const bf16_t*)(ws + WS_U); const bf16_t* OA = (const bf16_t*)(ws + WS_R1); const bf16_t* OC = OA + (size_t)T * 1024;
    const bf16_t* OB = (const bf16_t*)(ws + WS_OB); bf16_t* Gt = (bf16_t*)(ws + WS_QA);
    const float* b_lam = ap->in[11] + l * 256;
    const float lam_init = (l == 0) ? 0.2f : 0.35550906759f;
    float lam;
    { const float a = b_lam[lane] * b_lam[64 + lane], b = b_lam[128 + lane] * b_lam[192 + lane];
      lam = expf(xsum(a, 1, 32)) - expf(xsum(b, 1, 32)) + lam_init; }
    const int l15 = lane & 15;
    float g_sub[8]; load8f(ap->in[12] + l * 128 + l15 * 8, g_sub);
    for (int t = gw; t < T; t += NGW) {
        const bf16_t* ur = U + (size_t)t * NU; bf16_t* gr = Gt + (size_t)t * 3072; float f[8], z[8];
        u32x4 ra[2], za[2], rc[2], zc[2], rb0[2], rb1[2], zb[2];
#pragma unroll
        for (int hf = 0; hf < 2; ++hf) {
            ra[hf] = *(const u32x4*)(OA + (size_t)t * 1024 + hf * 512 + lane * 8); za[hf] = *(const u32x4*)(ur + UC_AZ + hf * 512 + lane * 8);
            rc[hf] = *(const u32x4*)(OC + (size_t)t * 1024 + hf * 512 + lane * 8); zc[hf] = *(const u32x4*)(ur + UC_CZ + hf * 512 + lane * 8);
            const int head = hf * 4 + (lane >> 4);
            rb0[hf] = *(const u32x4*)(OB + (size_t)t * 2048 + (2 * head) * 128 + l15 * 8); rb1[hf] = *(const u32x4*)(OB + (size_t)t * 2048 + (2 * head + 1) * 128 + l15 * 8);
            zb[hf] = *(const u32x4*)(ur + UC_BZ + head * 128 + l15 * 8); }
#pragma unroll
        for (int hf = 0; hf < 2; ++hf) {
            unpack8(ra[hf], f); unpack8(za[hf], z);
#pragma unroll
            for (int j = 0; j < 8; ++j) f[j] *= z[j];
            *(u32x4*)(gr + hf * 512 + lane * 8) = pack8(f);
            unpack8(rc[hf], f); unpack8(zc[hf], z);
#pragma unroll
            for (int j = 0; j < 8; ++j) f[j] *= z[j];
            *(u32x4*)(gr + 2048 + hf * 512 + lane * 8) = pack8(f);
        }
#pragma unroll
        for (int st = 0; st < 2; ++st) { const int head = st * 4 + (lane >> 4); float o1[8];
            unpack8(rb0[st], f); unpack8(rb1[st], o1);
#pragma unroll
            for (int j = 0; j < 8; ++j) f[j] = f[j] - lam * o1[j];
            const float rs = 1.0f / sqrtf(xsum(sumsq8(f), 1, 8) * (1.0f / 128) + EPS) * (1.0f - lam_init);
            unpack8(zb[st], z);
#pragma unroll
            for (int j = 0; j < 8; ++j) f[j] = f[j] * rs * g_sub[j] * z[j];
            *(u32x4*)(gr + 1024 + head * 128 + l15 * 8) = pack8(f); }
    }
}

DI void phase_gemm(const int l, const int k, LAS unsigned char* lds) {
    ArgsP ap = get_args();
    unsigned char* ws = ap->ws;
    bf16_t* U = (bf16_t*)(ws + WS_U);
    pg8::Gemm g; pg8::Sched S; pg8::Epi E;
    E.KAo = (bf16_t*)(ws + WS_KA); E.gk = ap->in[8] + l * 192; E.part = (LAS float*)(lds + 131072);
    E.U = U; E.YB = (float*)(U + UC_BQ); E.Xin = (l == 0) ? ap->in[0] : ap->out; E.Out = ap->out; E.act_by_pn = 0; E.mode = 0; E.ldc = NU; E.O = U;
    const int G = gridDim.x, c = blockIdx.x;
    if (k == 1)      { g.A = (const bf16_t*)(ws + WS_R1); g.Bt = (const bf16_t*)(ws + WS_WIN); g.lda = DM; g.K = DM; S.init(T, NU, DM, DM, 0, G, c); E.act_by_pn = 1; }
    else if (k == 3) { g.A = U + UC_CQ; g.Bt = (const bf16_t*)(ws + WS_WUQ); g.lda = NU; g.K = 512; S.init(T, 1536, NU, 512, 0, G, c); E.O = (bf16_t*)(ws + WS_QA); E.ldc = 1536; }
    else if (k == 4) { g.A = U + UC_CKV; g.Bt = (const bf16_t*)(ws + WS_WUKV); g.lda = NU; g.K = 256; S.init(T, 2048, NU, 256, 0, G, c); E.O = (bf16_t*)(ws + WS_KVA); E.ldc = 2048; E.mode = 4; }
    else if (k == 8) { g.A = (const bf16_t*)(ws + WS_G); g.Bt = (const bf16_t*)(ws + WS_WB); g.lda = 3072; g.K = 3072; S.init(T, DM, 3072, 3072, 0, G, c); E.mode = 2; E.O = (bf16_t*)(ws + WS_OB); E.ldc = DM; }
    else             { g.A = (const bf16_t*)(ws + WS_OB); g.Bt = (const bf16_t*)(ws + WS_WO); g.lda = DM; g.K = DM; S.init(T, DM, DM, DM, 0, G, c); E.mode = 3; }
    pg8::gemm_phase(lds, g, S, E);
}

__global__ void __launch_bounds__(512, 2) mk_fwd(Args args) {
    extern __shared__ __attribute__((aligned(16))) unsigned char shm[];
    LAS unsigned char* lds = (LAS unsigned char*)shm;
    cg::grid_group grid = cg::this_grid();
    volatile LAS unsigned* bst = (volatile LAS unsigned*)(lds + LDS_BYTES - 64);
    if (threadIdx.x < 2) bst[threadIdx.x] = 0u;
    __syncthreads();
    XcdBarrier xbar;
    { ArgsP ap0 = get_args(); xbar.bar = (unsigned*)(ap0->ws + WS_BAR); xbar.x = xb_xcc_id(); xbar.st = bst;
      if (blockIdx.x == 0) { u32x4* cw = (u32x4*)(ap0->ws + WS_CTL); for (int i = threadIdx.x; i < (int)(WS_CTL_BYTES / 16); i += 512) cw[i] = (u32x4){0u, 0u, 0u, 0u}; } }
    for (int step = 0; step < 10 * DEPTH; ++step) {
        const int l = step / 10, k = step - l * 10;
        if (k == 7 || k == 5) continue;
        if (false) continue;
        if (k == 1 || k == 3 || k == 4 || k == 8 || k == 9) { if (PH(2)) phase_gemm(l, k, lds); }
        else if (k == 0) { if (PH(0)) phase_prep(l, lds); }
        else if (k == 2) { if (PH(3)) phase_post_u(l); }
        else if (k == 5) { if (PH(5)) phase_post_a(l); }
        else if (k == 6) { if (PH(6)) phase_attn(l, lds); }
        if (k != 3 && step != 10 * DEPTH - 1) { if (step == 0) { grid.sync(); if (threadIdx.x == 0) (void)xb_add(&xbar.bar[XB_XCNT(xbar.x)], 1u); } else xcd_barrier(xbar); }
    }
}

extern "C" void kernel_launch(void* const* d_in, const int* in_sizes, int n_in, void* d_out, int out_size, void* d_ws, size_t ws_size, hipStream_t stream) {
    static int grid = 0;
    if (grid == 0) {
        if (n_in != 18 || in_sizes[0] != T * DM || out_size != T * DM || ws_size < WS_END) {
            fprintf(stderr, "kernel_launch: unexpected shapes / workspace (n_in %d, in0 %d, out %d, ws %zu, need %zu)\n", n_in, n_in > 0 ? in_sizes[0] : -1, out_size, ws_size, (size_t)WS_END);
            grid = -1; return; }
        int dev = 0, cus = 0, per_cu = 0;
        hipGetDevice(&dev);
        hipDeviceGetAttribute(&cus, hipDeviceAttributeMultiprocessorCount, dev);
        if (hipFuncSetAttribute((const void*)mk_fwd, hipFuncAttributeMaxDynamicSharedMemorySize, LDS_BYTES) != hipSuccess) { fprintf(stderr, "kernel_launch: hipFuncSetAttribute failed\n"); grid = -1; return; }
        if (hipOccupancyMaxActiveBlocksPerMultiprocessor(&per_cu, (const void*)mk_fwd, 512, LDS_BYTES) != hipSuccess || per_cu < 1) { fprintf(stderr, "kernel_launch: occupancy query gave %d\n", per_cu); per_cu = 1; }
        (void)hipGetLastError();
        grid = cus * 1;
    }
    if (grid < 0) return;
    Args a{};
    for (int i = 0; i < 18; ++i) a.in[i] = (const float*)d_in[i];
    a.out = (float*)d_out; a.ws = (unsigned char*)d_ws;
    void* kargs[] = {&a};
    hipError_t e = hipLaunchCooperativeKernel((const void*)mk_fwd, dim3(grid), dim3(512), kargs, LDS_BYTES, stream);
    if (e != hipSuccess) fprintf(stderr, "kernel_launch: cooperative launch failed: %s (grid %d)\n", hipGetErrorString(e), grid);
}
```

```cpp
#include <hip/hip_runtime.h>
#include <hip/hip_cooperative_groups.h>
#include <cstdio>
#include <cstdint>
namespace cg = cooperative_groups;
#ifndef PH_MASK
#define PH_MASK 0xFFFF
#endif
#define PH(k) ((PH_MASK >> (k)) & 1)

#define DI __device__ __forceinline__
#define LAS __attribute__((address_space(3)))
typedef unsigned short bf16_t;
typedef short bf16x8 __attribute__((ext_vector_type(8)));
typedef short s16x4 __attribute__((ext_vector_type(4)));
typedef float f32x4 __attribute__((ext_vector_type(4)));
typedef float f32x16 __attribute__((ext_vector_type(16)));
typedef unsigned u32x4 __attribute__((ext_vector_type(4)));

constexpr int T = 16384, SEQ = 4096, DM = 2048, DIN = 16192, NU = 16384, DEPTH = 2;
constexpr int UC_CQ = 0, UC_CKV = 512, UC_AZ = 1024, UC_BQ = 2048, UC_BK = 3072, UC_BV = 4096, UC_BZ = 5120,
              UC_CQ2 = 6144, UC_CK = 7168, UC_CV = 8192, UC_CZ = 9216, UC_GATE = 10240;
constexpr float EPS = 1e-6f, LOG2E = 1.4426950408889634f;

constexpr size_t al256(size_t x) { return (x + 255) / 256 * 256; }
constexpr size_t WS_CTL = 0;
constexpr size_t WS_BAR = 1024;
constexpr size_t WS_CTL_BYTES = 32768;
constexpr size_t WS_ROPE = WS_CTL_BYTES;
constexpr size_t WS_WIN = al256(WS_ROPE + (size_t)SEQ * 80 * 4);
constexpr size_t WS_WUQ = WS_WIN + (size_t)NU * DM * 2;
constexpr size_t WS_WUKV = WS_WUQ + (size_t)1536 * 512 * 2;
constexpr size_t WS_WB = WS_WUKV + (size_t)2048 * 256 * 2;
constexpr size_t WS_WO = WS_WB + (size_t)3 * 2048 * 1024 * 2;
constexpr size_t WS_U = WS_WO + (size_t)2048 * 2048 * 2;
constexpr size_t WS_R1 = WS_U + (size_t)T * NU * 2;
constexpr size_t WS_QA = WS_R1 + (size_t)T * 2048 * 2;
constexpr size_t WS_KVA = WS_QA + (size_t)T * 1536 * 2;
constexpr size_t WS_KA = WS_KVA + (size_t)T * 2048 * 2;
constexpr size_t WS_OB = WS_KA + (size_t)T * 1536 * 2;
constexpr size_t WS_G = WS_OB + (size_t)T * 2048 * 2;
constexpr size_t WS_END = WS_G + (size_t)T * 3072 * 2;

constexpr int LDS_BYTES = 147456;
constexpr int ATT_MISC = 4 * 16384 + 3 * 24576;
constexpr int ATT_BIAS = ATT_MISC + 2048;
constexpr int ATT_QW = ATT_BIAS + 1024;

DI unsigned pk2(float lo, float hi) { unsigned r; asm volatile("v_cvt_pk_bf16_f32 %0, %1, %2" : "=v"(r) : "v"(lo), "v"(hi)); return r; }
DI bf16_t f2bf(float x) { unsigned u = __float_as_uint(x); u += 0x7fffu + ((u >> 16) & 1u); return (bf16_t)(u >> 16); }
DI void unpack8(const u32x4 v, float (&f)[8]) {
    f[0] = __uint_as_float(v.x << 16); f[1] = __uint_as_float(v.x & 0xffff0000u);
    f[2] = __uint_as_float(v.y << 16); f[3] = __uint_as_float(v.y & 0xffff0000u);
    f[4] = __uint_as_float(v.z << 16); f[5] = __uint_as_float(v.z & 0xffff0000u);
    f[6] = __uint_as_float(v.w << 16); f[7] = __uint_as_float(v.w & 0xffff0000u);
}
DI u32x4 pack8(const float (&f)[8]) { u32x4 o; o.x = pk2(f[0], f[1]); o.y = pk2(f[2], f[3]); o.z = pk2(f[4], f[5]); o.w = pk2(f[6], f[7]); return o; }
DI void load8f(const float* p, float (&f)[8]) { const f32x4 a = *(const f32x4*)p, b = *(const f32x4*)(p + 4); f[0] = a.x; f[1] = a.y; f[2] = a.z; f[3] = a.w; f[4] = b.x; f[5] = b.y; f[6] = b.z; f[7] = b.w; }
DI float sumsq8(const float (&f)[8]) { float s = 0.f;
#pragma unroll
    for (int j = 0; j < 8; ++j) s += f[j] * f[j];
    return s; }
DI float xsum(float v, int lo, int hi) {
#pragma unroll
    for (int o = lo; o <= hi; o <<= 1) v += __shfl_xor(v, o);
    return v; }
DI float sigmoidf_(float v) { return __builtin_amdgcn_rcpf(1.f + __expf(-v)); }

namespace pg8 {
constexpr int BM = 256, BK = 64, HALF = 128, HTB = HALF * BK * 2, STAGE_BYTES = 8 * HTB, NXCD = 8, WGM = 8;
DI int lds_byte(int r, int c) { const int st = (r >> 4) * 2 + (c >> 5), rr = r & 15, cc = c & 31, ob = rr * 64 + cc * 2; return st * 1024 + (ob ^ (((ob >> 9) & 1) << 5)); }
DI void stage_rc(int b, int& R, int& C) { const int st = b / 1024, sb = b % 1024, swz = sb ^ (((sb >> 9) & 1) << 5); R = (st >> 1) * 16 + swz / 64; C = (st & 1) * 32 + (swz % 64) / 2; }
DI int perm32(int rho) { const int n = rho >> 4, i = rho & 15; return 8 * (i >> 2) + 4 * n + (i & 3); }

struct Unit { int pm, pn, sub; size_t aoff, boff; };
struct Gemm { const bf16_t* A; const bf16_t* Bt; int lda, K; };

DI void tile_of(int wgid, int nM, int nN, int& pm, int& pn) {
    const int nwg = nM * nN;
    { const int q = nwg / NXCD, r = nwg % NXCD, xcd = wgid % NXCD, off = wgid / NXCD; wgid = (xcd < r ? xcd * (q + 1) : r * (q + 1) + (xcd - r) * q) + off; }
    const int nig = WGM * nN, gid = wgid / nig, fm = gid * WGM, gsz = (nM - fm) < WGM ? (nM - fm) : WGM;
    pm = fm + ((wgid % nig) % gsz); pn = (wgid % nig) / gsz;
}
struct Sched {
    int nM, nN, nwg, G, c, lda, K, triple;
    DI void init(int M, int N, int lda_, int K_, int triple_, int G_, int c_) { nM = M / BM; nN = N / BM; nwg = nM * nN; G = G_; c = c_; lda = lda_; K = K_; triple = triple_; }
    DI bool next(int i, Unit& u) const {
        const int j = triple ? i / 3 : i; const long L = (long)j * G + c; if (L >= nwg) return false;
        tile_of((int)L, nM, nN, u.pm, u.pn); u.sub = triple ? i - 3 * j : 0;
        if (triple) { u.aoff = ((size_t)u.pm * BM * 3072 + (size_t)u.sub * 1024) * 2; u.boff = ((size_t)u.sub * 2048 + (size_t)u.pn * BM) * 1024 * 2; }
        else { u.aoff = (size_t)u.pm * BM * lda * 2; u.boff = (size_t)u.pn * BM * K * 2; }
        return true;
    }
};

struct Epi {
    static constexpr bool PERM = true;
    int mode, act_by_pn, ldc; bf16_t* O; const bf16_t* U; float* YB; const float* Xin; float* Out;
    bf16_t* KAo; const float* gk; LAS float* part;
    DI void operator()(const f32x4 (&acc)[2][2][4][2], const Unit& u, int wr, int wc, int fr, int fq) const {
        const int pn = u.pn;
        const int row0 = u.pm * BM + wr * 64 + fr, col0 = pn * BM + wc * 32 + 8 * fq;
        if (mode == 0) {
            const int act = !act_by_pn ? 0 : ((pn >= 40) ? 2 : (((pn >= 4 && pn < 8) || (pn >= 20 && pn < 24) || (pn >= 36 && pn < 40)) ? 1 : 0));
#pragma unroll
            for (int ai = 0; ai < 2; ++ai)
#pragma unroll
                for (int m = 0; m < 4; ++m) { bf16_t* rowp = O + (size_t)(row0 + ai * HALF + m * 16) * ldc + col0;
#pragma unroll
                    for (int bj = 0; bj < 2; ++bj) { f32x4 v0 = acc[ai][bj][m][0], v1 = acc[ai][bj][m][1];
                        if (act == 1) {
#pragma unroll
                            for (int j = 0; j < 4; ++j) { v0[j] = v0[j] * sigmoidf_(v0[j]); v1[j] = v1[j] * sigmoidf_(v1[j]); }
                        } else if (act == 2) {
#pragma unroll
                            for (int j = 0; j < 4; ++j) { v0[j] = sigmoidf_(v0[j]); v1[j] = sigmoidf_(v1[j]); }
                        }
                        u32x4 w; w.x = pk2(v0[0], v0[1]); w.y = pk2(v0[2], v0[3]); w.z = pk2(v1[0], v1[1]); w.w = pk2(v1[2], v1[3]);
                        *(u32x4*)(rowp + bj * HALF) = w; } }
        } else if (mode == 4) {
            float ss[2][4];
#pragma unroll
            for (int ai = 0; ai < 2; ++ai)
#pragma unroll
                for (int m = 0; m < 4; ++m) { const f32x4 a0 = acc[ai][0][m][0], a1 = acc[ai][0][m][1];
                    float v = (a0.x * a0.x + a0.y * a0.y) + (a0.z * a0.z + a0.w * a0.w) + (a1.x * a1.x + a1.y * a1.y) + (a1.z * a1.z + a1.w * a1.w);
                    v += __shfl_xor(v, 16); v += __shfl_xor(v, 32); ss[ai][m] = v; }
            if (fq == 0) {
#pragma unroll
                for (int ai = 0; ai < 2; ++ai)
#pragma unroll
                    for (int m = 0; m < 4; ++m) part[(ai * HALF + wr * 64 + m * 16 + fr) * 4 + wc] = ss[ai][m];
            }
            asm volatile("s_waitcnt lgkmcnt(0)" ::: "memory");
            __builtin_amdgcn_s_barrier();
            asm volatile("" ::: "memory");
            float gk8[8]; load8f(gk + wc * 32 + 8 * fq, gk8);
#pragma unroll
            for (int ai = 0; ai < 2; ++ai)
#pragma unroll
                for (int m = 0; m < 4; ++m) { const int rl = ai * HALF + wr * 64 + m * 16 + fr; const size_t row = (size_t)(u.pm * BM + rl);
                    const f32x4 pv = *(const LAS f32x4*)(part + rl * 4);
                    const float rs = 1.0f / sqrtf(((pv.x + pv.y) + (pv.z + pv.w)) * (1.0f / 128) + EPS);
                    { const f32x4 v0 = acc[ai][0][m][0], v1 = acc[ai][0][m][1];
                      u32x4 w; w.x = pk2(v0[0] * rs * gk8[0], v0[1] * rs * gk8[1]); w.y = pk2(v0[2] * rs * gk8[2], v0[3] * rs * gk8[3]);
                      w.z = pk2(v1[0] * rs * gk8[4], v1[1] * rs * gk8[5]); w.w = pk2(v1[2] * rs * gk8[6], v1[3] * rs * gk8[7]);
                      *(u32x4*)(KAo + row * 1536 + pn * 192 + wc * 32 + 8 * fq) = w; }
                    { const f32x4 v0 = acc[ai][1][m][0], v1 = acc[ai][1][m][1];
                      u32x4 w; w.x = pk2(v0[0], v0[1]); w.y = pk2(v0[2], v0[3]); w.z = pk2(v1[0], v1[1]); w.w = pk2(v1[2], v1[3]);
                      *(u32x4*)(O + row * ldc + col0 + HALF) = w; } }
        } else if (mode == 2) {
#pragma unroll
            for (int ai = 0; ai < 2; ++ai) { u32x4 gv[4][2];
#pragma unroll
                for (int m = 0; m < 4; ++m)
#pragma unroll
                    for (int bj = 0; bj < 2; ++bj) gv[m][bj] = *(const u32x4*)(U + (size_t)(row0 + ai * HALF + m * 16) * NU + UC_GATE + 2 * 2048 + col0 + bj * HALF);
#pragma unroll
                for (int m = 0; m < 4; ++m) { const size_t row = (size_t)(row0 + ai * HALF + m * 16);
#pragma unroll
                    for (int bj = 0; bj < 2; ++bj) { const int col = col0 + bj * HALF;
                        float g[8]; unpack8(gv[m][bj], g);
#pragma unroll
                        for (int j = 0; j < 8; ++j) g[j] = fmaxf(g[j], 1e-30f);
                        const f32x4 a0 = acc[ai][bj][m][0], a1 = acc[ai][bj][m][1];
                        u32x4 w; w.x = pk2(a0[0] * g[0], a0[1] * g[1]); w.y = pk2(a0[2] * g[2], a0[3] * g[3]); w.z = pk2(a1[0] * g[4], a1[1] * g[5]); w.w = pk2(a1[2] * g[6], a1[3] * g[7]);
                        *(u32x4*)(O + row * DM + col) = w; } }
                __builtin_amdgcn_sched_barrier(0); }
        } else {
#pragma unroll
            for (int ai = 0; ai < 2; ++ai) { f32x4 xv[4][2][2];
#pragma unroll
                for (int m = 0; m < 4; ++m)
#pragma unroll
                    for (int bj = 0; bj < 2; ++bj)
#pragma unroll
                        for (int n = 0; n < 2; ++n) xv[m][bj][n] = __builtin_nontemporal_load((const f32x4*)(Xin + (size_t)(row0 + ai * HALF + m * 16) * DM + col0 + bj * HALF + n * 4));
#pragma unroll
                for (int m = 0; m < 4; ++m)
#pragma unroll
                    for (int bj = 0; bj < 2; ++bj)
#pragma unroll
                        for (int n = 0; n < 2; ++n) *(f32x4*)(Out + (size_t)(row0 + ai * HALF + m * 16) * DM + col0 + bj * HALF + n * 4) = xv[m][bj][n] + acc[ai][bj][m][n];
                __builtin_amdgcn_sched_barrier(0); }
        }
    }
    DI void rescale(f32x4 (&acc)[2][2][4][2], const Unit& u, int seg, int wr, int wc, int fr, int fq) const {
        int row0 = u.pm * BM + wr * 64 + fr, col0 = u.pn * BM + wc * 32 + 8 * fq;
        asm volatile("" : "+v"(row0), "+v"(col0));
#pragma unroll
        for (int ai = 0; ai < 2; ++ai)
#pragma unroll
        for (int mh = 0; mh < 2; ++mh) { u32x4 rr[2][4];
#pragma unroll
            for (int mm = 0; mm < 2; ++mm) { const bf16_t* gp = U + (size_t)(row0 + ai * HALF + (mh * 2 + mm) * 16) * NU + UC_GATE + (seg - 1) * 2048 + col0;
                rr[mm][0] = *(const u32x4*)(gp); rr[mm][1] = *(const u32x4*)(gp + HALF); rr[mm][2] = *(const u32x4*)(gp + 2048); rr[mm][3] = *(const u32x4*)(gp + 2048 + HALF); }
            asm volatile("s_waitcnt vmcnt(0)" ::: "memory");
#pragma unroll
            for (int mm = 0; mm < 2; ++mm)
#pragma unroll
                for (int bj = 0; bj < 2; ++bj) { const int m = mh * 2 + mm;
                    float g[8], gn[8]; unpack8(rr[mm][bj], g); unpack8(rr[mm][2 + bj], gn);
#pragma unroll
                    for (int j = 0; j < 8; ++j) g[j] = fmaxf(g[j], 1e-30f) * __builtin_amdgcn_rcpf(fmaxf(gn[j], 1e-30f));
                    f32x4 a0 = acc[ai][bj][m][0], a1 = acc[ai][bj][m][1];
                    a0.x *= g[0]; a0.y *= g[1]; a0.z *= g[2]; a0.w *= g[3];
                    a1.x *= g[4]; a1.y *= g[5]; a1.z *= g[6]; a1.w *= g[7];
                    acc[ai][bj][m][0] = a0; acc[ai][bj][m][1] = a1; }
            __builtin_amdgcn_sched_barrier(0); }
    }
};

DI void gemm_phase(LAS unsigned char* lds, const Gemm g, const Sched& S, const Epi& E) {
    int tid_ = threadIdx.x; asm volatile("" : "+v"(tid_));
    const int tid = tid_, wid = __builtin_amdgcn_readfirstlane(tid >> 6), lane = tid & 63, wr = wid >> 2, wc = wid & 3, fr = lane & 15, fq = lane >> 4;
    const int K = g.K, lda = g.lda, nt = K / BK;
    unsigned voffA[2], voffB[2];
#pragma unroll
    for (int i = 0; i < 2; ++i) { int R, C; stage_rc(tid * 16 + i * 8192, R, C); const int Rb = Epi::PERM ? ((R & ~31) + perm32(R & 31)) : R;
        voffA[i] = (unsigned)(R * lda + C) * 2u; voffB[i] = (unsigned)(Rb * K + C) * 2u; }
    const size_t kstep = (size_t)(BK * 2);
    const size_t hstepA = (size_t)HALF * lda * 2, hstepB = (size_t)HALF * K * 2;
    const unsigned ldsw = (unsigned)wid * 1024u;
    const int aoff = lds_byte(wr * 64 + fr, fq * 8), boff = lds_byte(wc * 32 + fr, fq * 8);
#define PG8_SA(b, h) (((b) * 2 + (h)) * HTB)
#define PG8_SB(b, h) ((4 + (b) * 2 + (h)) * HTB)
#define PG8_STAGE(bufoff, gbase, voff) do { _Pragma("unroll") for (int _i = 0; _i < 2; ++_i) \
        __builtin_amdgcn_global_load_lds((const unsigned*)((const char*)(gbase) + (voff)[_i]), (LAS unsigned*)(lds + (bufoff) + ldsw + _i * 8192), 16, 0, 0); } while (0)
#define PG8_LDA(dst, b, h) do { _Pragma("unroll") for (int m = 0; m < 4; ++m) _Pragma("unroll") for (int k = 0; k < 2; ++k) dst[m][k] = *(const LAS bf16x8*)(lds + PG8_SA(b, h) + aoff + m * 2048 + k * 1024); } while (0)
#define PG8_LDB(dst, b, h) do { _Pragma("unroll") for (int n = 0; n < 2; ++n) _Pragma("unroll") for (int k = 0; k < 2; ++k) dst[n][k] = *(const LAS bf16x8*)(lds + PG8_SB(b, h) + boff + n * 2048 + k * 1024); } while (0)
#define PG8_MMA(ai, bj, At, Bt) do { __builtin_amdgcn_s_setprio(1); _Pragma("unroll") for (int m = 0; m < 4; ++m) _Pragma("unroll") for (int n = 0; n < 2; ++n) _Pragma("unroll") for (int k = 0; k < 2; ++k) \
        acc[ai][bj][m][n] = __builtin_amdgcn_mfma_f32_16x16x32_bf16(Bt[n][k], At[m][k], acc[ai][bj][m][n], 0, 0, 0); __builtin_amdgcn_s_setprio(0); } while (0)
#define PG8_WAIT_V(n) asm volatile("s_waitcnt vmcnt(" #n ")" ::: "memory")
#define PG8_WAIT_L(n) asm volatile("s_waitcnt lgkmcnt(" #n ")" ::: "memory")
#define PG8_BAR __builtin_amdgcn_s_barrier()
#define PG8_SCHED __builtin_amdgcn_sched_barrier(0)
    Unit cur, nxt; int ui = 0;
    if (!S.next(0, cur)) return;
    f32x4 acc[2][2][4][2];
#pragma unroll
    for (int a = 0; a < 2; ++a)
#pragma unroll
        for (int b = 0; b < 2; ++b)
#pragma unroll
            for (int m = 0; m < 4; ++m)
#pragma unroll
                for (int n = 0; n < 2; ++n) acc[a][b][m][n] = (f32x4){0.f, 0.f, 0.f, 0.f};
    bf16x8 At[4][2], B0[2][2], B1[2][2];
    const char* cA = (const char*)g.A + cur.aoff; const char* cB = (const char*)g.Bt + cur.boff;
    PG8_STAGE(PG8_SB(0, 0), cB, voffB); PG8_STAGE(PG8_SB(0, 1), cB + hstepB, voffB); PG8_STAGE(PG8_SA(0, 0), cA, voffA); PG8_STAGE(PG8_SA(0, 1), cA + hstepA, voffA);
    if (wr == 1) PG8_BAR;
    PG8_WAIT_V(2); PG8_BAR;
    PG8_STAGE(PG8_SB(1, 0), cB + kstep, voffB); PG8_STAGE(PG8_SA(1, 0), cA + kstep, voffA); PG8_STAGE(PG8_SB(1, 1), cB + hstepB + kstep, voffB);
    PG8_WAIT_V(6); PG8_BAR;
    for (;;) {
        const bool has_next = S.next(ui + 1, nxt);
        const char* nA = has_next ? (const char*)g.A + nxt.aoff : cA; const char* nB = has_next ? (const char*)g.Bt + nxt.boff : cB;
        for (int t = 0; t < nt; t += 2) {
            if (E.mode == 2 && (t == 16 || t == 32)) E.rescale(acc, cur, t >> 4, wr, wc, fr, fq);
            const bool last = (t == nt - 2);
            const char* a1 = cA + (size_t)(t + 1) * kstep;
            const char* a2 = last ? nA : cA + (size_t)(t + 2) * kstep; const char* b2 = last ? nB : cB + (size_t)(t + 2) * kstep;
            const char* a3 = a2 + kstep; const char* b3 = b2 + kstep;
            PG8_LDB(B0, 0, 0); PG8_LDB(B1, 0, 1); PG8_SCHED; PG8_LDA(At, 0, 0); PG8_STAGE(PG8_SA(1, 1), a1 + hstepA, voffA);
            PG8_WAIT_V(8); PG8_WAIT_L(0); PG8_BAR; PG8_MMA(0, 0, At, B0); PG8_MMA(0, 1, At, B1); PG8_BAR; PG8_SCHED;
            PG8_LDA(At, 0, 1); PG8_STAGE(PG8_SB(0, 0), b2, voffB); PG8_STAGE(PG8_SB(0, 1), b2 + hstepB, voffB); PG8_STAGE(PG8_SA(0, 0), a2, voffA);
            PG8_WAIT_V(8); PG8_WAIT_L(0); PG8_BAR; PG8_MMA(1, 0, At, B0); PG8_MMA(1, 1, At, B1); PG8_BAR; PG8_SCHED;
            PG8_LDB(B0, 1, 0); PG8_LDB(B1, 1, 1); PG8_SCHED; PG8_LDA(At, 1, 0); PG8_STAGE(PG8_SA(0, 1), a2 + hstepA, voffA);
            PG8_WAIT_V(8); PG8_WAIT_L(0); PG8_BAR; PG8_MMA(0, 0, At, B0); PG8_MMA(0, 1, At, B1); PG8_BAR; PG8_SCHED;
            PG8_LDA(At, 1, 1); PG8_STAGE(PG8_SB(1, 0), b3, voffB); PG8_STAGE(PG8_SB(1, 1), b3 + hstepB, voffB); PG8_STAGE(PG8_SA(1, 0), a3, voffA);
            PG8_WAIT_V(8); PG8_WAIT_L(0); PG8_BAR; PG8_MMA(1, 0, At, B0); PG8_MMA(1, 1, At, B1); PG8_BAR; PG8_SCHED;
        }
        if (wr == 0) PG8_BAR;
        E(acc, cur, wr, wc, fr, fq);
        if (!has_next) break;
#pragma unroll
        for (int a = 0; a < 2; ++a)
#pragma unroll
            for (int b = 0; b < 2; ++b)
#pragma unroll
                for (int m = 0; m < 4; ++m)
#pragma unroll
                    for (int n = 0; n < 2; ++n) acc[a][b][m][n] = (f32x4){0.f, 0.f, 0.f, 0.f};
        cur = nxt; cA = nA; cB = nB; ++ui;
        if (wr == 1) PG8_BAR;
    }
    PG8_WAIT_V(0);
    PG8_BAR;
#undef PG8_SA
#undef PG8_SB
#undef PG8_STAGE
#undef PG8_LDA
#undef PG8_LDB
#undef PG8_MMA
#undef PG8_WAIT_V
#undef PG8_WAIT_L
#undef PG8_BAR
#undef PG8_SCHED
}
}

DI int crow(int r, int hi) { return (r & 3) + 8 * (r >> 2) + 4 * hi; }
DI int v_st(int k, int c) { const int kk = (k & ~0xC) | ((k & 4) << 1) | ((k & 8) >> 1); return ((kk >> 3) * 4 + (c >> 5)) * 512 + ((kk & 7) * 32 + (c & 31)) * 2; }
DI int v_rd_base(int lane) { return ((lane & 3) << 3) | (((lane >> 2) & 3) << 6) | (((lane >> 4) & 1) << 5) | (((lane >> 5) & 1) << 8); }
constexpr int v_rd_off(int d0, int ks, int half) { return d0 * 512 + ks * 4096 + half * 2048; }
template <int OFF> DI s16x4 tr_read(int vb) { s16x4 r; asm volatile("ds_read_b64_tr_b16 %0, %1 offset:%2" : "=&v"(r) : "v"(vb), "i"(OFF) : "memory"); return r; }
template <int D0> DI void pv_one(f32x16& od, int vb, bf16x8 pa0, bf16x8 pa1, bf16x8 pa2, bf16x8 pa3) {
    const s16x4 l0 = tr_read<v_rd_off(D0, 0, 0)>(vb), h0 = tr_read<v_rd_off(D0, 0, 1)>(vb), l1 = tr_read<v_rd_off(D0, 1, 0)>(vb), h1 = tr_read<v_rd_off(D0, 1, 1)>(vb);
    const s16x4 l2 = tr_read<v_rd_off(D0, 2, 0)>(vb), h2 = tr_read<v_rd_off(D0, 2, 1)>(vb), l3 = tr_read<v_rd_off(D0, 3, 0)>(vb), h3 = tr_read<v_rd_off(D0, 3, 1)>(vb);
    asm volatile("s_waitcnt lgkmcnt(0)" ::: "memory"); __builtin_amdgcn_sched_barrier(0);
#define PK(L, H) (bf16x8){L[0], L[1], L[2], L[3], H[0], H[1], H[2], H[3]}
    od = __builtin_amdgcn_mfma_f32_32x32x16_bf16(pa0, PK(l0, h0), od, 0, 0, 0);
    od = __builtin_amdgcn_mfma_f32_32x32x16_bf16(pa1, PK(l1, h1), od, 0, 0, 0);
    od = __builtin_amdgcn_mfma_f32_32x32x16_bf16(pa2, PK(l2, h2), od, 0, 0, 0);
    od = __builtin_amdgcn_mfma_f32_32x32x16_bf16(pa3, PK(l3, h3), od, 0, 0, 0);
#undef PK
}
template <int DQK> DI int kswz(int row, int cb) { return row * (DQK * 2) + (cb ^ ((row & 7) << 4)); }

template <int DQK, bool BIAS, int ldq, int ldk, int ldv, int ldo>
DI void attn_unit(const float* __restrict__ gq, const float* __restrict__ ropec, const float* __restrict__ ropes, const int pos0,
                  const bf16_t* __restrict__ Qb, const bf16_t* __restrict__ Kb, const bf16_t* __restrict__ Vb, bf16_t* __restrict__ Ob,
                  const int blk_lo, const int blk_hi, const int cw, const float C, LAS unsigned char* lds,
                  const int epi, const bf16_t* __restrict__ Zb, const bf16_t* __restrict__ O0b, const float lam, const float post, const float* __restrict__ gsub) {
    constexpr int NKC = DQK / 64, ND = DQK / 16, SHV = 16384, SHK = 64 * DQK * 2, KOFF = 4 * SHV, RB = DQK * 2;
    constexpr float THR_L2 = 6.0f;
    int tid_ = threadIdx.x; asm volatile("" : "+v"(tid_));
    const int tid = tid_, wid = __builtin_amdgcn_readfirstlane(tid >> 6), lane = tid & 63, r32 = lane & 31, hi = lane >> 5;
    const bool late = wid >= 4;
    LAS float* misc = (LAS float*)(lds + ATT_MISC) + wid * 64; LAS float* li_l = misc; LAS float* al_l = misc + 32;
    const LAS float* bias_l = (const LAS float*)(lds + ATT_BIAS);
    const int w_lo = BIAS ? (cw > 8 ? cw - 8 : 0) : 0, w_hi = cw;
    float m_reg = -1e30f, l_reg = 0.f;
    f32x16 o[4];
#pragma unroll
    for (int d = 0; d < 4; ++d)
#pragma unroll
        for (int r = 0; r < 16; ++r) o[d][r] = 0.f;
    bf16x8 qr[ND];
    { const bf16_t* Qw = Qb + (size_t)(wid * 32 + r32) * ldq + hi * 8;
#pragma unroll
      for (int d0 = 0; d0 < ND; ++d0) qr[d0] = *(const bf16x8*)(Qw + d0 * 16);
      { const int pos = pos0 + wid * 32 + r32;
        float qf[ND][8]; float ssn = 0.f, ssr = 0.f;
#pragma unroll
        for (int d0 = 0; d0 < ND; ++d0) { unpack8(__builtin_bit_cast(u32x4, qr[d0]), qf[d0]); const float sq = sumsq8(qf[d0]); if (DQK == 192 && d0 >= 8) ssr += sq; else ssn += sq; }
        { auto rr = __builtin_amdgcn_permlane32_swap(__float_as_uint(ssn), __float_as_uint(ssn), false, false); ssn = __uint_as_float(rr[0]) + __uint_as_float(rr[1]); }
        if (DQK == 192) { auto rr = __builtin_amdgcn_permlane32_swap(__float_as_uint(ssr), __float_as_uint(ssr), false, false); ssr = __uint_as_float(rr[0]) + __uint_as_float(rr[1]); }
        const float rsn = 1.0f / sqrtf(ssn * (DQK == 64 ? (1.0f / 64) : (1.0f / 128)) + EPS), rsr = 1.0f / sqrtf(ssr * (1.0f / 64) + EPS);
#pragma unroll
        for (int d0 = 0; d0 < ND; ++d0) { float g[8]; load8f(gq + d0 * 16 + hi * 8, g); const float rs = (DQK == 192 && d0 >= 8) ? rsr : rsn;
#pragma unroll
            for (int j = 0; j < 8; ++j) qf[d0][j] = qf[d0][j] * rs * g[j]; }
        if (DQK == 64) {
            float cs[8], sn[8]; load8f(ropec + pos * 8, cs); load8f(ropes + pos * 8, sn);
#pragma unroll
            for (int j = 0; j < 8; ++j) { auto rr = __builtin_amdgcn_permlane32_swap(__float_as_uint(qf[0][j]), __float_as_uint(qf[0][j]), false, false);
                const float other = __uint_as_float(hi ? rr[0] : rr[1]);
                qf[0][j] = hi ? qf[0][j] * cs[j] + other * sn[j] : qf[0][j] * cs[j] - other * sn[j]; }
        }
        if (DQK == 192) {
#pragma unroll
            for (int dd = 0; dd < 2; ++dd) { float cs[8], sn[8]; load8f(ropec + pos * 32 + dd * 16 + hi * 8, cs); load8f(ropes + pos * 32 + dd * 16 + hi * 8, sn);
#pragma unroll
                for (int j = 0; j < 8; ++j) { const float x1 = qf[(DQK == 192 ? 8 : 0) + dd][j], x2 = qf[(DQK == 192 ? 10 : 0) + dd][j];
                    qf[(DQK == 192 ? 8 : 0) + dd][j] = x1 * cs[j] - x2 * sn[j]; qf[(DQK == 192 ? 10 : 0) + dd][j] = x2 * cs[j] + x1 * sn[j]; } }
        }
#pragma unroll
        for (int d0 = 0; d0 < ND; ++d0) qr[d0] = __builtin_bit_cast(bf16x8, pack8(qf[d0]));
      }
#pragma unroll
      for (int d0 = 0; d0 < ND; ++d0) asm volatile("" : "+v"(qr[d0])); }
    unsigned goffK[NKC], goffV[2];
#pragma unroll
    for (int i = 0; i < NKC; ++i) { const int ob = (i * 8 + wid) * 1024 + lane * 16, row = ob / RB, cbs = ob - row * RB, cb = cbs ^ ((row & 7) << 4); goffK[i] = (unsigned)(row * ldk + (cb >> 1)); }
#pragma unroll
    for (int i = 0; i < 2; ++i) { const int ob = (i * 8 + wid) * 1024 + lane * 16, st = ob >> 9, w = (ob & 511) >> 1, kk = ((st >> 2) << 3) | (w >> 5);
        const int k = (kk & ~0xC) | ((kk & 4) << 1) | ((kk & 8) >> 1), c = (st & 3) * 32 + (w & 31); goffV[i] = (unsigned)(k * ldv + c); }
    const int vb0 = (int)(size_t)(lds) + v_rd_base(lane);
#define AT_DMA(t, kslot, vslot) do { const bf16_t* kp_ = Kb + (size_t)((t) * 64) * ldk; const bf16_t* vp_ = Vb + (size_t)((t) * 64) * ldv; \
        _Pragma("unroll") for (int i_ = 0; i_ < NKC; ++i_) __builtin_amdgcn_global_load_lds((const unsigned*)(kp_ + goffK[i_]), (LAS unsigned*)(lds + KOFF + (kslot) * SHK + (i_ * 8 + wid) * 1024), 16, 0, 0); \
        _Pragma("unroll") for (int i_ = 0; i_ < 2; ++i_) __builtin_amdgcn_global_load_lds((const unsigned*)(vp_ + goffV[i_]), (LAS unsigned*)(lds + (vslot) * SHV + (i_ * 8 + wid) * 1024), 16, 0, 0); } while (0)
#define AT_PV(vb_) do { __builtin_amdgcn_s_setprio(1); pv_one<0>(o[0], (vb_), pa0, pa1, pa2, pa3); pv_one<1>(o[1], (vb_), pa0, pa1, pa2, pa3); pv_one<2>(o[2], (vb_), pa0, pa1, pa2, pa3); pv_one<3>(o[3], (vb_), pa0, pa1, pa2, pa3); __builtin_amdgcn_s_setprio(0); } while (0)
    AT_DMA(blk_lo, 0, 0);
    if (blk_lo + 1 <= blk_hi) AT_DMA(blk_lo + 1, 1, 1);
    constexpr bool PIPE = (DQK == 64) && !BIAS;
    if constexpr (PIPE) {
        f32x16 pA0, pA1, pB0, pB1;
        bf16x8 pa0, pa1, pa2, pa3;
        int ksn = 0;
#define PQK(P0, P1, kslot_) do { __builtin_amdgcn_s_setprio(1); _Pragma("unroll") for (int r_ = 0; r_ < 16; ++r_) { P0[r_] = 0.f; P1[r_] = 0.f; } \
            const LAS unsigned char* Ks_ = lds + KOFF + (kslot_) * SHK; \
            _Pragma("unroll") for (int d0_ = 0; d0_ < ND; ++d0_) { const int cb_ = (d0_ * 16 + hi * 8) * 2; \
                const bf16x8 b0_ = *(const LAS bf16x8*)(Ks_ + kswz<DQK>(r32, cb_)); const bf16x8 b1_ = *(const LAS bf16x8*)(Ks_ + kswz<DQK>(32 + r32, cb_)); \
                P0 = __builtin_amdgcn_mfma_f32_32x32x16_bf16(b0_, qr[d0_], P0, 0, 0, 0); P1 = __builtin_amdgcn_mfma_f32_32x32x16_bf16(b1_, qr[d0_], P1, 0, 0, 0); } __builtin_amdgcn_s_setprio(0); } while (0)
#define PK4(P, BASE, OUT) do { unsigned a0 = pk2(P[BASE + 0], P[BASE + 1]), a1 = pk2(P[BASE + 2], P[BASE + 3]);   \
    unsigned b0 = pk2(P[BASE + 4], P[BASE + 5]), b1 = pk2(P[BASE + 6], P[BASE + 7]);                              \
    auto r0 = __builtin_amdgcn_permlane32_swap(a0, b0, false, false); auto r1 = __builtin_amdgcn_permlane32_swap(a1, b1, false, false); \
    u32x4 w = {r0[0], r1[0], r0[1], r1[1]}; OUT = *reinterpret_cast<bf16x8*>(&w); } while (0)
#define PSMPV(P0, P1, tt_) do { float mx_ = P0[0]; \
            _Pragma("unroll") for (int r_ = 1; r_ < 16; ++r_) mx_ = fmaxf(mx_, P0[r_]); \
            _Pragma("unroll") for (int r_ = 0; r_ < 16; ++r_) mx_ = fmaxf(mx_, P1[r_]); \
            { auto rr_ = __builtin_amdgcn_permlane32_swap(__float_as_uint(mx_), __float_as_uint(mx_), false, false); mx_ = fmaxf(__uint_as_float(rr_[0]), __uint_as_float(rr_[1])); } \
            mx_ *= C; float alpha_ = 1.f; const bool keep_ = __all(mx_ - m_reg <= THR_L2); \
            if (!keep_) { const float mn_ = fmaxf(m_reg, mx_); alpha_ = __builtin_amdgcn_exp2f(m_reg - mn_); m_reg = mn_; } \
            { const float nm_ = -m_reg; _Pragma("unroll") for (int r_ = 0; r_ < 16; ++r_) { P0[r_] = __builtin_amdgcn_exp2f(fmaf(P0[r_], C, nm_)); P1[r_] = __builtin_amdgcn_exp2f(fmaf(P1[r_], C, nm_)); } } \
            float ps_ = 0.f; _Pragma("unroll") for (int r_ = 0; r_ < 16; ++r_) ps_ += P0[r_]; _Pragma("unroll") for (int r_ = 0; r_ < 16; ++r_) ps_ += P1[r_]; \
            { auto rr_ = __builtin_amdgcn_permlane32_swap(__float_as_uint(ps_), __float_as_uint(ps_), false, false); ps_ = __uint_as_float(rr_[0]) + __uint_as_float(rr_[1]); } \
            l_reg = l_reg * alpha_ + ps_; \
            PK4(P0, 0, pa0); PK4(P0, 8, pa1); PK4(P1, 0, pa2); PK4(P1, 8, pa3); \
            if (!keep_) { if (hi == 0) al_l[r32] = alpha_; asm volatile("s_waitcnt lgkmcnt(0)" ::: "memory"); \
                _Pragma("unroll") for (int r_ = 0; r_ < 16; ++r_) { const float a_ = al_l[crow(r_, hi)]; _Pragma("unroll") for (int d_ = 0; d_ < 4; ++d_) o[d_][r_] *= a_; } } \
            const int vb_ = vb0 + (((tt_) - blk_lo) & 3) * SHV; AT_PV(vb_); } while (0)
#define PSTEP(tt_, PC0, PC1, PN0, PN1) do { \
            if ((tt_) + 2 <= blk_hi) asm volatile("s_waitcnt vmcnt(3) lgkmcnt(0)" ::: "memory"); else asm volatile("s_waitcnt vmcnt(0) lgkmcnt(0)" ::: "memory"); \
            __builtin_amdgcn_s_barrier(); asm volatile("" ::: "memory"); \
            if ((tt_) + 3 <= blk_hi) { const int s3_ = (ksn >= 1) ? ksn - 1 : 2; AT_DMA((tt_) + 3, s3_, ((tt_) + 3 - blk_lo) & 3); } \
            if ((tt_) + 1 >= w_lo && (tt_) + 1 <= w_hi) PQK(PN0, PN1, ksn); \
            if ((tt_) >= w_lo && (tt_) <= w_hi) PSMPV(PC0, PC1, (tt_)); \
            ksn = (ksn == 2) ? 0 : ksn + 1; } while (0)
        for (int t = blk_lo - 1; t <= blk_hi; t += 2) {
            PSTEP(t, pA0, pA1, pB0, pB1);
            if (t + 1 <= blk_hi) PSTEP(t + 1, pB0, pB1, pA0, pA1);
        }
#undef PSTEP
#undef PSMPV
#undef PK4
#undef PQK
    } else {
    int slot = 0;
    bf16x8 pa0, pa1, pa2, pa3;
    bool pend = false; int pend_vb = 0;
    for (int t = blk_lo; t <= blk_hi; ++t) {
        if (t + 1 <= blk_hi) { if constexpr (NKC == 1) asm volatile("s_waitcnt vmcnt(3) lgkmcnt(0)" ::: "memory"); else if constexpr (NKC == 2) asm volatile("s_waitcnt vmcnt(4) lgkmcnt(0)" ::: "memory"); else asm volatile("s_waitcnt vmcnt(5) lgkmcnt(0)" ::: "memory"); }
        else asm volatile("s_waitcnt vmcnt(0) lgkmcnt(0)" ::: "memory");
        __builtin_amdgcn_s_barrier();
        asm volatile("" ::: "memory");
        if (t + 2 <= blk_hi) { const int s2 = (slot >= 1) ? slot - 1 : 2; AT_DMA(t + 2, s2, (t + 2 - blk_lo) & 3); }
        if (pend) { AT_PV(pend_vb); pend = false; }
        if (t >= w_lo && t <= w_hi) {
            f32x16 p0, p1;
#pragma unroll
            for (int r = 0; r < 16; ++r) { p0[r] = 0.f; p1[r] = 0.f; }
            const LAS unsigned char* Ks = lds + KOFF + slot * SHK;
            __builtin_amdgcn_s_setprio(1);
#pragma unroll
            for (int d0 = 0; d0 < ND; ++d0) { const int cb = (d0 * 16 + hi * 8) * 2;
                const bf16x8 b0 = *(const LAS bf16x8*)(Ks + kswz<DQK>(r32, cb));
                const bf16x8 b1 = *(const LAS bf16x8*)(Ks + kswz<DQK>(32 + r32, cb));
                p0 = __builtin_amdgcn_mfma_f32_32x32x16_bf16(b0, qr[d0], p0, 0, 0, 0);
                p1 = __builtin_amdgcn_mfma_f32_32x32x16_bf16(b1, qr[d0], p1, 0, 0, 0); }
            __builtin_amdgcn_s_setprio(0);
            float mx;
            if (BIAS) {
                const int dch = cw - t;
                if (dch >= 3) { const float bc = bias_l[191];
#pragma unroll
                    for (int r = 0; r < 16; ++r) { p0[r] = fmaf(p0[r], C, bc); p1[r] = fmaf(p1[r], C, bc); }
                } else { const int base = dch * 64 + (wid & 1) * 32 + r32 + 63;
#pragma unroll
                    for (int r = 0; r < 16; ++r) { const int kk = crow(r, hi); const int i0 = base - kk, i1 = base - kk - 32;
                        p0[r] = fmaf(p0[r], C, bias_l[i0 > 191 ? 191 : i0]); p1[r] = fmaf(p1[r], C, bias_l[i1 > 191 ? 191 : i1]); }
                }
            }
            mx = p0[0];
#pragma unroll
            for (int r = 1; r < 16; ++r) mx = fmaxf(mx, p0[r]);
#pragma unroll
            for (int r = 0; r < 16; ++r) mx = fmaxf(mx, p1[r]);
            { auto rr = __builtin_amdgcn_permlane32_swap(__float_as_uint(mx), __float_as_uint(mx), false, false);
              mx = fmaxf(__uint_as_float(rr[0]), __uint_as_float(rr[1])); }
            if (!BIAS) mx *= C;
            float alpha = 1.f;
            const bool keep = __all(mx - m_reg <= THR_L2);
            if (!keep) { const float mn = fmaxf(m_reg, mx); alpha = __builtin_amdgcn_exp2f(m_reg - mn); m_reg = mn; }
            if (BIAS) {
#pragma unroll
                for (int r = 0; r < 16; ++r) { p0[r] = __builtin_amdgcn_exp2f(p0[r] - m_reg); p1[r] = __builtin_amdgcn_exp2f(p1[r] - m_reg); }
            } else { const float nm = -m_reg;
#pragma unroll
                for (int r = 0; r < 16; ++r) { p0[r] = __builtin_amdgcn_exp2f(fmaf(p0[r], C, nm)); p1[r] = __builtin_amdgcn_exp2f(fmaf(p1[r], C, nm)); }
            }
            float ps = 0.f;
#pragma unroll
            for (int r = 0; r < 16; ++r) ps += p0[r];
#pragma unroll
            for (int r = 0; r < 16; ++r) ps += p1[r];
            { auto rr = __builtin_amdgcn_permlane32_swap(__float_as_uint(ps), __float_as_uint(ps), false, false);
              ps = __uint_as_float(rr[0]) + __uint_as_float(rr[1]); }
            l_reg = l_reg * alpha + ps;
#define PK4(P, BASE, OUT) do { unsigned a0 = pk2(P[BASE + 0], P[BASE + 1]), a1 = pk2(P[BASE + 2], P[BASE + 3]);   \
    unsigned b0 = pk2(P[BASE + 4], P[BASE + 5]), b1 = pk2(P[BASE + 6], P[BASE + 7]);                              \
    auto r0 = __builtin_amdgcn_permlane32_swap(a0, b0, false, false); auto r1 = __builtin_amdgcn_permlane32_swap(a1, b1, false, false); \
    u32x4 w = {r0[0], r1[0], r0[1], r1[1]}; OUT = *reinterpret_cast<bf16x8*>(&w); } while (0)
            PK4(p0, 0, pa0); PK4(p0, 8, pa1); PK4(p1, 0, pa2); PK4(p1, 8, pa3);
#undef PK4
            if (!keep) {
                if (hi == 0) al_l[r32] = alpha;
                asm volatile("s_waitcnt lgkmcnt(0)" ::: "memory");
#pragma unroll
                for (int r = 0; r < 16; ++r) { const float a = al_l[crow(r, hi)];
#pragma unroll
                    for (int d = 0; d < 4; ++d) o[d][r] *= a; }
            }
            const int vb = vb0 + ((t - blk_lo) & 3) * SHV;
            if (late) { pend = true; pend_vb = vb; }
            else AT_PV(vb);
        }
        slot = (slot == 2) ? 0 : slot + 1;
    }
    if (pend) AT_PV(pend_vb);
    }
#undef AT_DMA
#undef AT_PV
    if (hi == 0) li_l[r32] = l_reg;
    asm volatile("s_waitcnt lgkmcnt(0)" ::: "memory");
    float rli[16];
#pragma unroll
    for (int r = 0; r < 16; ++r) rli[r] = __builtin_amdgcn_rcpf(li_l[crow(r, hi)]);
    bf16_t* Ow = Ob + (size_t)(wid * 32) * ldo;
    if (epi == 0) {
#pragma unroll
        for (int r = 0; r < 16; ++r) { const int orow = crow(r, hi);
#pragma unroll
            for (int d0 = 0; d0 < 4; ++d0) Ow[(size_t)orow * ldo + d0 * 32 + r32] = f2bf(o[d0][r] * rli[r]); }
    } else if (epi == 1) {
        const bf16_t* Zw = Zb + (size_t)(wid * 32) * NU;
        bf16_t zr[16][4];
#pragma unroll
        for (int r = 0; r < 16; ++r) { const int orow = crow(r, hi);
#pragma unroll
            for (int d0 = 0; d0 < 4; ++d0) zr[r][d0] = Zw[(size_t)orow * NU + d0 * 32 + r32]; }
#pragma unroll
        for (int r = 0; r < 16; ++r) { const int orow = crow(r, hi);
#pragma unroll
            for (int d0 = 0; d0 < 4; ++d0) { const float z = __uint_as_float((unsigned)zr[r][d0] << 16);
                Ow[(size_t)orow * ldo + d0 * 32 + r32] = f2bf(o[d0][r] * rli[r] * z); } }
    } else {
        const bf16_t* Zw = Zb + (size_t)(wid * 32) * NU; const bf16_t* O0w = O0b + (size_t)(wid * 32) * ldo;
        float gs[4];
#pragma unroll
        for (int d0 = 0; d0 < 4; ++d0) gs[d0] = gsub[d0 * 32 + r32] * post;
        bf16_t zr[16][4], o0r[16][4];
#pragma unroll
        for (int r = 0; r < 16; ++r) { const int orow = crow(r, hi);
#pragma unroll
            for (int d0 = 0; d0 < 4; ++d0) { zr[r][d0] = Zw[(size_t)orow * NU + d0 * 32 + r32]; o0r[r][d0] = O0w[(size_t)orow * ldo + d0 * 32 + r32]; } }
#pragma unroll
        for (int r = 0; r < 16; ++r) { const int orow = crow(r, hi); float d[4]; float ss = 0.f;
#pragma unroll
            for (int d0 = 0; d0 < 4; ++d0) { const float o0 = __uint_as_float((unsigned)o0r[r][d0] << 16);
                d[d0] = o0 - lam * (o[d0][r] * rli[r]); ss += d[d0] * d[d0]; }
            ss = xsum(ss, 1, 16);
            const float rs = 1.0f / sqrtf(ss * (1.0f / 128) + EPS);
#pragma unroll
            for (int d0 = 0; d0 < 4; ++d0) { const float z = __uint_as_float((unsigned)zr[r][d0] << 16);
                Ow[(size_t)orow * ldo + d0 * 32 + r32] = f2bf(d[d0] * rs * gs[d0] * z); } }
    }
    __syncthreads();
}

#define XB_TMO      128
#define XB_XCNT(j)  (256  + 64 * (j))
#define XB_XSUB(j)  (1280 + 64 * (j))
#define XB_XGEN(j)  (2304 + 64 * (j))
#define XB_TOP      3328
#define XB_TOPGEN   3392
#define XCD_BAR_WORDS 3456
#define XB_SPIN_CAP (1u << 20)
DI unsigned xb_ld(unsigned* p)              { return __hip_atomic_load(p, __ATOMIC_RELAXED, __HIP_MEMORY_SCOPE_AGENT); }
DI unsigned xb_add(unsigned* p, unsigned v) { return __hip_atomic_fetch_add(p, v, __ATOMIC_RELAXED, __HIP_MEMORY_SCOPE_AGENT); }
DI unsigned xb_xcc_id() { return (unsigned)__builtin_amdgcn_s_getreg((3 << 11) | 20) & 0xFu; }
#define XB_SPIN(cond, bar) do { unsigned _sp = 0; while (cond) {   \
    if ((++_sp & 255u) == 0u) { if (xb_ld(&(bar)[XB_TMO])) break; if (_sp > XB_SPIN_CAP) { atomicAdd(&(bar)[XB_TMO], 1u); break; } } } } while (0)
struct XcdBarrier { unsigned* bar; unsigned x; volatile LAS unsigned* st; };
DI XcdBarrier xcd_barrier_post(unsigned* bar, volatile LAS unsigned* st) {
    XcdBarrier b; b.bar = bar; b.x = xb_xcc_id(); b.st = st;
    if (threadIdx.x == 0) (void)xb_add(&bar[XB_XCNT(b.x)], 1u);
    return b;
}
DI void xcd_barrier_complete(unsigned* bar, unsigned x, unsigned& nloc, unsigned& nx) {
    const unsigned G = gridDim.x * gridDim.y * gridDim.z;
    unsigned sum, cnt, mine, sp = 0u;
    for (;;) {
        sum = 0u; cnt = 0u; mine = 0u;
#pragma unroll
        for (unsigned j = 0; j < 16; ++j) { const unsigned c = xb_ld(&bar[XB_XCNT(j)]); sum += c; cnt += (c > 0u) ? 1u : 0u; mine = (j == x) ? c : mine; }
        if (sum == G) break;
        __builtin_amdgcn_s_sleep(1);
        if ((++sp & 255u) == 0u) { if (xb_ld(&bar[XB_TMO])) break; if (sp > XB_SPIN_CAP) { atomicAdd(&bar[XB_TMO], 1u); break; } }
    }
    nloc = mine > 0u ? mine : 1u; nx = cnt > 0u ? cnt : 1u;
}
DI void xcd_barrier(const XcdBarrier& b) {
    asm volatile("s_waitcnt vmcnt(0)" ::: "memory");
    __syncthreads();
    if (threadIdx.x == 0) {
        unsigned* bar = b.bar;
        __builtin_amdgcn_s_waitcnt(0);
        unsigned nloc = b.st[0], nx = b.st[1];
        if (nloc == 0u) { xcd_barrier_complete(bar, b.x, nloc, nx); b.st[0] = nloc; b.st[1] = nx; }
        const unsigned old = xb_add(&bar[XB_XSUB(b.x)], 1u);
        const unsigned gen = old / nloc;
        if (old + 1u == (gen + 1u) * nloc) {
            __builtin_amdgcn_fence(__ATOMIC_RELEASE, "agent");
            asm volatile("s_waitcnt vmcnt(0)" ::: "memory");
            const unsigned og = xb_add(&bar[XB_TOP], 1u);
            const unsigned tg = og / nx;
            if (og + 1u == (tg + 1u) * nx) xb_add(&bar[XB_TOPGEN], 1u);
            else XB_SPIN(xb_ld(&bar[XB_TOPGEN]) == tg, bar);
            __builtin_amdgcn_fence(__ATOMIC_ACQUIRE, "agent");
            xb_add(&bar[XB_XGEN(b.x)], 1u);
            asm volatile("s_waitcnt vmcnt(0)" ::: "memory");
        } else {
            XB_SPIN(xb_ld(&bar[XB_XGEN(b.x)]) == gen, bar);
            __builtin_amdgcn_fence(__ATOMIC_ACQUIRE, "agent");
            asm volatile("s_waitcnt vmcnt(0)" ::: "memory");
        }
    }
    __syncthreads();
}

struct Args {
    const float* in[18];
    float* out; unsigned char* ws;
};

DI void transpose_item(const float* __restrict__ W, int K, int N, bf16_t* __restrict__ WT, int ldw, int koff, bool remap, LAS float* scr, int item, int lane) {
    const int nblk = N / 32, kb = item / nblk, nb = item - kb * nblk, k0 = 64 * kb, n0 = 32 * nb;
    float v[32];
    const float* src = W + (size_t)(k0 + (lane >> 5)) * N + n0 + (lane & 31);
#pragma unroll
    for (int i = 0; i < 32; ++i) v[i] = src[(size_t)(2 * i) * N];
#pragma unroll
    for (int i = 0; i < 32; ++i) scr[(2 * i + (lane >> 5)) * 33 + (lane & 31)] = v[i];
    asm volatile("s_waitcnt lgkmcnt(0)" ::: "memory");
    int d0 = n0; if (remap && n0 >= 832) d0 += 192;
    const int c = lane & 7;
#pragma unroll
    for (int j = 0; j < 4; ++j) { const int n = (lane >> 3) + 8 * j; const LAS float* s = scr + (8 * c) * 33 + n;
        u32x4 o; o.x = pk2(s[0 * 33], s[1 * 33]); o.y = pk2(s[2 * 33], s[3 * 33]); o.z = pk2(s[4 * 33], s[5 * 33]); o.w = pk2(s[6 * 33], s[7 * 33]);
        *(u32x4*)(WT + (size_t)(d0 + n) * ldw + koff + k0 + 8 * c) = o; }
    asm volatile("s_waitcnt lgkmcnt(0)" ::: "memory");
}

typedef const __attribute__((address_space(4))) Args* ArgsP;
DI ArgsP get_args() { ArgsP ap = (ArgsP)__builtin_amdgcn_kernarg_segment_ptr(); asm volatile("" : "+s"(ap)); return ap; }

DI void phase_prep(const int l, LAS unsigned char* lds) {
    ArgsP ap = get_args();
    int tid_ = threadIdx.x; asm volatile("" : "+v"(tid_));
    const int tid = tid_, lane = tid & 63, wid = __builtin_amdgcn_readfirstlane(tid >> 6);
    const int G = gridDim.x, gw = blockIdx.x * 8 + wid, NGW = G * 8;
    unsigned char* ws = ap->ws;
    bf16_t* WIN = (bf16_t*)(ws + WS_WIN);
    if (l == 0) {
        float* ropeT = (float*)(ws + WS_ROPE);
        for (int idx = blockIdx.x * 512 + tid; idx < SEQ * 40; idx += G * 512) {
            const int pos = idx / 40, k = idx - pos * 40;
            float inv; if (k < 32) inv = 1.0f / powf(10000.0f, (float)(2 * k) / 64.0f); else inv = 1.0f / powf(500000.0f, (float)(2 * (k - 32)) / 16.0f);
            const float ang = (float)pos * inv;
            double rev = (double)ang * 0.15915494309189535; rev -= floor(rev);
            const float fr = (float)rev; const float cs = __builtin_amdgcn_cosf(fr), sn = __builtin_amdgcn_sinf(fr);
            if (k < 32) { ropeT[pos * 32 + k] = cs; ropeT[SEQ * 32 + pos * 32 + k] = sn; }
            else { ropeT[SEQ * 64 + pos * 8 + (k - 32)] = cs; ropeT[SEQ * 72 + pos * 8 + (k - 32)] = sn; }
        }
    }
    for (int i = blockIdx.x * 512 + tid; i < 192 * DM / 8; i += G * 512) *(u32x4*)(WIN + (size_t)832 * DM + (size_t)i * 8) = (u32x4){0u, 0u, 0u, 0u};
    {
        const float* w_in = ap->in[2] + (size_t)l * DM * DIN;
        const float* a_w_uq = ap->in[5] + (size_t)l * 512 * 1536; const float* a_w_ukv = ap->in[6] + (size_t)l * 256 * 2048;
        const float* w_branch = ap->in[16] + (size_t)l * 3 * 1024 * 2048; const float* w_out = ap->in[17] + (size_t)l * DM * DM;
        bf16_t* WUQ = (bf16_t*)(ws + WS_WUQ); bf16_t* WUKV = (bf16_t*)(ws + WS_WUKV); bf16_t* WB = (bf16_t*)(ws + WS_WB); bf16_t* WO = (bf16_t*)(ws + WS_WO);
        LAS float* scr = (LAS float*)(lds) + wid * (64 * 33);
        constexpr int I_IN = (DM / 64) * (DIN / 32), I_UQ = (512 / 64) * (1536 / 32), I_UKV = (256 / 64) * (2048 / 32), I_BR = (1024 / 64) * (2048 / 32), I_OUT = (DM / 64) * (DM / 32);
        constexpr int NITEMS = I_IN + I_UQ + I_UKV + 3 * I_BR + I_OUT;
        for (int it = gw; it < NITEMS; it += NGW) {
            int r = it;
            if (r < I_IN) { transpose_item(w_in, DM, DIN, WIN, DM, 0, true, scr, r, lane); continue; } r -= I_IN;
            if (r < I_UQ) { transpose_item(a_w_uq, 512, 1536, WUQ, 512, 0, false, scr, r, lane); continue; } r -= I_UQ;
            if (r < I_UKV) { transpose_item(a_w_ukv, 256, 2048, WUKV, 256, 0, false, scr, r, lane); continue; } r -= I_UKV;
            if (r < 3 * I_BR) { const int n = r / I_BR; transpose_item(w_branch + (size_t)n * 1024 * 2048, 1024, 2048, WB, 3072, n * 1024, false, scr, r - n * I_BR, lane); continue; } r -= 3 * I_BR;
            transpose_item(w_out, DM, DM, WO, DM, 0, false, scr, r, lane);
        }
    }
    {
        const float* xin = (l == 0) ? ap->in[0] : ap->out; const float* g_pre = ap->in[1] + (size_t)l * DM; bf16_t* H = (bf16_t*)(ws + WS_R1);
        for (int t = gw; t < T; t += NGW) {
            const float* xr = xin + (size_t)t * DM; f32x4 v[8]; float ss = 0.f;
#pragma unroll
            for (int j = 0; j < 8; ++j) { v[j] = *(const f32x4*)(xr + j * 256 + lane * 4); ss += (v[j].x * v[j].x + v[j].y * v[j].y) + (v[j].z * v[j].z + v[j].w * v[j].w); }
            ss = xsum(ss, 1, 32);
            const float rs = 1.0f / sqrtf(ss * (1.0f / DM) + EPS);
#pragma unroll
            for (int j = 0; j < 8; ++j) { const f32x4 g = *(const f32x4*)(g_pre + j * 256 + lane * 4);
                uint2 o; o.x = pk2(v[j].x * rs * g.x, v[j].y * rs * g.y); o.y = pk2(v[j].z * rs * g.z, v[j].w * rs * g.w);
                *(uint2*)(H + (size_t)t * DM + j * 256 + lane * 4) = o; }
        }
    }
}

DI void phase_post_u(const int l) {
    ArgsP ap = get_args();
    int tid_ = threadIdx.x; asm volatile("" : "+v"(tid_));
    const int tid = tid_, lane = tid & 63, wid = __builtin_amdgcn_readfirstlane(tid >> 6);
    const int gw = blockIdx.x * 8 + wid, NGW = gridDim.x * 8;
    unsigned char* ws = ap->ws;
    const float* ropeT = (const float*)(ws + WS_ROPE);
    const float* cosA = ropeT; const float* sinA = ropeT + SEQ * 32; const float* cosB = ropeT + SEQ * 64; const float* sinB = ropeT + SEQ * 72;
    bf16_t* U = (bf16_t*)(ws + WS_U); bf16_t* KA = (bf16_t*)(ws + WS_KA);
    const bool is_kr = (lane >= 32 && lane < 40);
    float g_cq[8], g_kv[8], g_bq[8], g_bk[8], g_cq2[8], g_ck[8];
    load8f(ap->in[3] + l * 512 + lane * 8, g_cq);
    load8f(is_kr ? ap->in[8] + l * 192 + 128 + (lane - 32) * 8 : ap->in[4] + l * 256 + (lane & 31) * 8, g_kv);
    load8f(ap->in[9] + l * 64 + (lane & 7) * 8, g_bq); load8f(ap->in[10] + l * 64 + (lane & 7) * 8, g_bk);
    load8f(ap->in[13] + l * 128 + (lane & 15) * 8, g_cq2); load8f(ap->in[14] + l * 128 + (lane & 15) * 8, g_ck);
    const int iA = (lane & 3) * 8, l7 = lane & 7;
    for (int t = gw; t < T; t += NGW) {
        bf16_t* ur = U + (size_t)t * NU; const int pos = t & (SEQ - 1);
        u32x4 raw[10];
        raw[0] = *(const u32x4*)(ur + UC_CQ + lane * 8); raw[1] = *(const u32x4*)(ur + UC_CKV + lane * 8);
#pragma unroll
        for (int hf = 0; hf < 2; ++hf) { raw[4 + hf] = *(const u32x4*)(ur + UC_BK + hf * 512 + lane * 8); raw[8 + hf] = *(const u32x4*)(ur + UC_CK + hf * 512 + lane * 8); }
        float csA[8], snA[8], csB[8], snB[8];
        load8f(cosA + pos * 32 + iA, csA); load8f(sinA + pos * 32 + iA, snA); load8f(cosB + pos * 8, csB); load8f(sinB + pos * 8, snB);
        float f[8];
        {
            unpack8(raw[0], f);
            const float rs = 1.0f / sqrtf(xsum(sumsq8(f), 1, 32) * (1.0f / 512) + EPS);
#pragma unroll
            for (int j = 0; j < 8; ++j) f[j] = f[j] * rs * g_cq[j];
            *(u32x4*)(ur + UC_CQ + lane * 8) = pack8(f);
        }
        {
            unpack8(raw[1], f);
            const float s8 = xsum(sumsq8(f), 1, 4), s32 = xsum(s8, 8, 16);
            const float rs = is_kr ? 1.0f / sqrtf(s8 * (1.0f / 64) + EPS) : 1.0f / sqrtf(s32 * (1.0f / 256) + EPS);
#pragma unroll
            for (int j = 0; j < 8; ++j) f[j] = f[j] * rs * g_kv[j];
            float yp[8];
#pragma unroll
            for (int j = 0; j < 8; ++j) yp[j] = __shfl_xor(f[j], 4);
            if (lane < 32) *(u32x4*)(ur + UC_CKV + lane * 8) = pack8(f);
            if (is_kr) {
                const bool first = (lane < 36); float o[8];
#pragma unroll
                for (int j = 0; j < 8; ++j) o[j] = first ? f[j] * csA[j] - yp[j] * snA[j] : f[j] * csA[j] + yp[j] * snA[j];
                const u32x4 pk = pack8(o);
#pragma unroll
                for (int h = 0; h < 8; ++h) *(u32x4*)(KA + (size_t)t * 1536 + h * 192 + 128 + (lane - 32) * 8) = pk;
            }
        }
#pragma unroll
        for (int w = 1; w < 2; ++w) {
#pragma unroll
            for (int hf = 0; hf < 2; ++hf) { bf16_t* p = ur + (w ? UC_BK : UC_BQ) + hf * 512 + lane * 8;
                unpack8(raw[2 + 2 * w + hf], f);
                const float rs = 1.0f / sqrtf(xsum(sumsq8(f), 1, 4) * (1.0f / 64) + EPS);
#pragma unroll
                for (int j = 0; j < 8; ++j) f[j] = f[j] * rs * (w ? g_bk[j] : g_bq[j]);
                float yp[8];
#pragma unroll
                for (int j = 0; j < 8; ++j) yp[j] = __shfl_xor(f[j], 1);
                if (l7 < 2) {
#pragma unroll
                    for (int j = 0; j < 8; ++j) f[j] = (l7 == 0) ? f[j] * csB[j] - yp[j] * snB[j] : f[j] * csB[j] + yp[j] * snB[j]; }
                *(u32x4*)p = pack8(f); } }
#pragma unroll
        for (int w = 1; w < 2; ++w) {
#pragma unroll
            for (int hf = 0; hf < 2; ++hf) { bf16_t* p = ur + (w ? UC_CK : UC_CQ2) + hf * 512 + lane * 8;
                unpack8(raw[6 + 2 * w + hf], f);
                const float rs = 1.0f / sqrtf(xsum(sumsq8(f), 1, 8) * (1.0f / 128) + EPS);
#pragma unroll
                for (int j = 0; j < 8; ++j) f[j] = f[j] * rs * (w ? g_ck[j] : g_cq2[j]);
                *(u32x4*)p = pack8(f); } }
    }
}

DI void phase_post_a(const int l) {
    ArgsP ap = get_args();
    int tid_ = threadIdx.x; asm volatile("" : "+v"(tid_));
    const int tid = tid_, lane = tid & 63, wid = __builtin_amdgcn_readfirstlane(tid >> 6);
    const int gw = blockIdx.x * 8 + wid, NGW = gridDim.x * 8;
    unsigned char* ws = ap->ws;
    const float* ropeT = (const float*)(ws + WS_ROPE);
    const float* cosA = ropeT; const float* sinA = ropeT + SEQ * 32;
    bf16_t* QA = (bf16_t*)(ws + WS_QA); bf16_t* KVA = (bf16_t*)(ws + WS_KVA); bf16_t* KA = (bf16_t*)(ws + WS_KA);
    const int slot = lane & 31, l31 = lane & 31; const bool act = slot < 24, rope = slot >= 16;
    float g_q[8], g_k[8];
    load8f(ap->in[7] + l * 192 + (act ? slot * 8 : 0), g_q); load8f(ap->in[8] + l * 192 + (l31 & 15) * 8, g_k);
    const int iA = (slot & 3) * 8;
    for (int t = gw; t < T; t += NGW) {
        const int pos = t & (SEQ - 1); float f[8];
        u32x4 rq[4], rk[4];
#pragma unroll
        for (int st = 0; st < 4; ++st) { const int head = st * 2 + (lane >> 5);
            rk[st] = *(const u32x4*)(KVA + (size_t)t * 2048 + head * 256 + l31 * 8); }
#pragma unroll
        for (int st = 0; st < 4; ++st) {
            const int head = st * 2 + (lane >> 5);
            unpack8(rk[st], f);
            const float rs = 1.0f / sqrtf(xsum(sumsq8(f), 1, 8) * (1.0f / 128) + EPS);
#pragma unroll
            for (int j = 0; j < 8; ++j) f[j] = f[j] * rs * g_k[j];
            if (l31 < 16) *(u32x4*)(KA + (size_t)t * 1536 + head * 192 + l31 * 8) = pack8(f);
        }
    }
}

DI int q_fetch(unsigned* ctr, LAS unsigned* qw) {
    if (threadIdx.x == 0) *qw = atomicAdd(ctr, 1u);
    __syncthreads();
    return __builtin_amdgcn_readfirstlane((int)*qw);
}
DI void phase_attn(const int l, LAS unsigned char* lds) {
    LAS unsigned* qw = (LAS unsigned*)(lds + ATT_QW);
#if PH(11)
    {
        ArgsP ap = get_args(); unsigned char* ws = ap->ws; unsigned* ctl = (unsigned*)(ws + WS_CTL) + l * 4;
        int tid = threadIdx.x; asm volatile("" : "+v"(tid)); const int wid = __builtin_amdgcn_readfirstlane(tid >> 6), lane = tid & 63;
        const float* b_lam = ap->in[11] + l * 256; const float* gsub = ap->in[12] + l * 128;
        const float lam_init = (l == 0) ? 0.2f : 0.35550906759f;
        float lam;
        { const float a = b_lam[lane] * b_lam[64 + lane], b2 = b_lam[128 + lane] * b_lam[192 + lane];
          lam = expf(xsum(a, 1, 32)) - expf(xsum(b2, 1, 32)) + lam_init; }
        for (;;) {
            const int idx = q_fetch(ctl + 1, qw);
            if (idx >= 512) break;
            const int qblk = 15 - (idx >> 5), r = idx & 31, b = r >> 3, h = r & 7; const size_t tok0 = (size_t)b * SEQ, q0 = tok0 + (size_t)qblk * 256;
            bf16_t* U = (bf16_t*)(ws + WS_U); bf16_t* Gt = (bf16_t*)(ws + WS_G);
            for (int c = 0; c < 2; ++c) {
                const int hc = h * 2 + c;
                bf16_t* outp = Gt + q0 * 3072 + 1024 + h * 128;
                attn_unit<64, false, NU, NU, NU, 3072>(ap->in[9] + l * 64, (const float*)(ws + WS_ROPE) + SEQ * 64, (const float*)(ws + WS_ROPE) + SEQ * 72, qblk * 256,
                                     U + q0 * NU + UC_BQ + hc * 64, U + tok0 * NU + UC_BK + hc * 64, U + tok0 * NU + UC_BV + h * 128,
                                     outp, 0, qblk * 4 + 3, qblk * 4 + (wid >> 1), 0.125f * LOG2E, lds,
                                     c ? 2 : 0, U + q0 * NU + UC_BZ + h * 128, outp, lam, 1.0f - lam_init, gsub);
            }
        }
    }
#endif
#if PH(10)
    {
        ArgsP ap = get_args(); unsigned char* ws = ap->ws; unsigned* ctl = (unsigned*)(ws + WS_CTL) + l * 4;
        int wid = threadIdx.x >> 6; asm volatile("" : "+v"(wid)); wid = __builtin_amdgcn_readfirstlane(wid);
        for (;;) {
            const int idx = q_fetch(ctl + 0, qw);
            if (idx >= 512) break;
            const int qblk = 15 - (idx >> 5), r = idx & 31, b = r >> 3, h = r & 7; const size_t tok0 = (size_t)b * SEQ, q0 = tok0 + (size_t)qblk * 256;
            bf16_t* QA = (bf16_t*)(ws + WS_QA); bf16_t* KVA = (bf16_t*)(ws + WS_KVA); bf16_t* KA = (bf16_t*)(ws + WS_KA); bf16_t* Gt = (bf16_t*)(ws + WS_G);
            const bf16_t* U = (const bf16_t*)(ws + WS_U);
            attn_unit<192, false, 1536, 1536, 2048, 3072>(ap->in[7] + l * 192, (const float*)(ws + WS_ROPE), (const float*)(ws + WS_ROPE) + SEQ * 32, qblk * 256,
                                  QA + q0 * 1536 + h * 192, KA + tok0 * 1536 + h * 192, KVA + tok0 * 2048 + h * 256 + 128,
                                  Gt + q0 * 3072 + h * 128, 0, qblk * 4 + 3, qblk * 4 + (wid >> 1), 0.07216878364870322f * LOG2E, lds,
                                  1, U + q0 * NU + UC_AZ + h * 128, nullptr, 0.f, 0.f, nullptr);
        }
    }
#endif
#if PH(12)
    {
        ArgsP ap = get_args(); unsigned char* ws = ap->ws; unsigned* ctl = (unsigned*)(ws + WS_CTL) + l * 4;
        const float* c_rel = ap->in[15] + l * 8 * 192;
        int wid = threadIdx.x >> 6; asm volatile("" : "+v"(wid)); wid = __builtin_amdgcn_readfirstlane(wid);
        for (;;) {
            const int idx = q_fetch(ctl + 2, qw);
            if (idx >= 512) break;
            const int qblk = 15 - (idx >> 5), r = idx & 31, b = r >> 3, h = r & 7; const size_t tok0 = (size_t)b * SEQ, q0 = tok0 + (size_t)qblk * 256;
            bf16_t* U = (bf16_t*)(ws + WS_U); bf16_t* Gt = (bf16_t*)(ws + WS_G);
            if (threadIdx.x < 192) ((LAS float*)(lds + ATT_BIAS))[threadIdx.x] = c_rel[h * 192 + threadIdx.x] * LOG2E;
            const int lo = qblk * 4 - 8;
            attn_unit<128, true, NU, NU, NU, 3072>(ap->in[13] + l * 128, nullptr, nullptr, qblk * 256,
                                 U + q0 * NU + UC_CQ2 + h * 128, U + tok0 * NU + UC_CK + h * 128, U + tok0 * NU + UC_CV + h * 128,
                                 Gt + q0 * 3072 + 2048 + h * 128, lo > 0 ? lo : 0, qblk * 4 + 3, qblk * 4 + (wid >> 1), 0.08838834764831845f * LOG2E, lds,
                                 1, U + q0 * NU + UC_CZ + h * 128, nullptr, 0.f, 0.f, nullptr);
        }
    }
#endif
}

DI void phase_gate(const int l) {
    ArgsP ap = get_args();
    int tid_ = threadIdx.x; asm volatile("" : "+v"(tid_));
    const int tid = tid_, lane = tid & 63, wid = __builtin_amdgcn_readfirstlane(tid >> 6);
    const int gw = blockIdx.x * 8 + wid, NGW = gridDim.x * 8;
    unsigned char* ws = ap->ws;
    const bf16_t* U = (const bf16_t*)(ws + WS_U); const bf16_t* OA = (const bf16_t*)(ws + WS_R1); const bf16_t* OC = OA + (size_t)T * 1024;
    const bf16_t* OB = (const bf16_t*)(ws + WS_OB); bf16_t* Gt = (bf16_t*)(ws + WS_QA);
    const float* b_lam = ap->in[11] + l * 256;
    const float lam_init = (l == 0) ? 0.2f : 0.35550906759f;
    float lam;
    { const float a = b_lam[lane] * b_lam[64 + lane], b = b_lam[128 + lane] * b_lam[192 + lane];
      lam = expf(xsum(a, 1, 32)) - expf(xsum(b, 1, 32)) + lam_init; }
    const int l15 = lane & 15;
    float g_sub[8]; load8f(ap->in[12] + l * 128 + l15 * 8, g_sub);
    for (int t = gw; t < T; t += NGW) {
        const bf16_t* ur = U + (size_t)t * NU; bf16_t* gr = Gt + (size_t)t * 3072; float f[8], z[8];
        u32x4 ra[2], za[2], rc[2], zc[2], rb0[2], rb1[2], zb[2];
#pragma unroll
        for (int hf = 0; hf < 2; ++hf) {
            ra[hf] = *(const u32x4*)(OA + (size_t)t * 1024 + hf * 512 + lane * 8); za[hf] = *(const u32x4*)(ur + UC_AZ + hf * 512 + lane * 8);
            rc[hf] = *(const u32x4*)(OC + (size_t)t * 1024 + hf * 512 + lane * 8); zc[hf] = *(const u32x4*)(ur + UC_CZ + hf * 512 + lane * 8);
            const int head = hf * 4 + (lane >> 4);
            rb0[hf] = *(const u32x4*)(OB + (size_t)t * 2048 + (2 * head) * 128 + l15 * 8); rb1[hf] = *(const u32x4*)(OB + (size_t)t * 2048 + (2 * head + 1) * 128 + l15 * 8);
            zb[hf] = *(const u32x4*)(ur + UC_BZ + head * 128 + l15 * 8); }
#pragma unroll
        for (int hf = 0; hf < 2; ++hf) {
            unpack8(ra[hf], f); unpack8(za[hf], z);
#pragma unroll
            for (int j = 0; j < 8; ++j) f[j] *= z[j];
            *(u32x4*)(gr + hf * 512 + lane * 8) = pack8(f);
            unpack8(rc[hf], f); unpack8(zc[hf], z);
#pragma unroll
            for (int j = 0; j < 8; ++j) f[j] *= z[j];
            *(u32x4*)(gr + 2048 + hf * 512 + lane * 8) = pack8(f);
        }
#pragma unroll
        for (int st = 0; st < 2; ++st) { const int head = st * 4 + (lane >> 4); float o1[8];
            unpack8(rb0[st], f); unpack8(rb1[st], o1);
#pragma unroll
            for (int j = 0; j < 8; ++j) f[j] = f[j] - lam * o1[j];
            const float rs = 1.0f / sqrtf(xsum(sumsq8(f), 1, 8) * (1.0f / 128) + EPS) * (1.0f - lam_init);
            unpack8(zb[st], z);
#pragma unroll
            for (int j = 0; j < 8; ++j) f[j] = f[j] * rs * g_sub[j] * z[j];
            *(u32x4*)(gr + 1024 + head * 128 + l15 * 8) = pack8(f); }
    }
}

DI void phase_gemm(const int l, const int k, LAS unsigned char* lds) {
    ArgsP ap = get_args();
    unsigned char* ws = ap->ws;
    bf16_t* U = (bf16_t*)(ws + WS_U);
    pg8::Gemm g; pg8::Sched S; pg8::Epi E;
    E.KAo = (bf16_t*)(ws + WS_KA); E.gk = ap->in[8] + l * 192; E.part = (LAS float*)(lds + 131072);
    E.U = U; E.YB = (float*)(U + UC_BQ); E.Xin = (l == 0) ? ap->in[0] : ap->out; E.Out = ap->out; E.act_by_pn = 0; E.mode = 0; E.ldc = NU; E.O = U;
    const int G = gridDim.x, c = blockIdx.x;
    if (k == 1)      { g.A = (const bf16_t*)(ws + WS_R1); g.Bt = (const bf16_t*)(ws + WS_WIN); g.lda = DM; g.K = DM; S.init(T, NU, DM, DM, 0, G, c); E.act_by_pn = 1; }
    else if (k == 3) { g.A = U + UC_CQ; g.Bt = (const bf16_t*)(ws + WS_WUQ); g.lda = NU; g.K = 512; S.init(T, 1536, NU, 512, 0, G, c); E.O = (bf16_t*)(ws + WS_QA); E.ldc = 1536; }
    else if (k == 4) { g.A = U + UC_CKV; g.Bt = (const bf16_t*)(ws + WS_WUKV); g.lda = NU; g.K = 256; S.init(T, 2048, NU, 256, 0, G, c); E.O = (bf16_t*)(ws + WS_KVA); E.ldc = 2048; E.mode = 4; }
    else if (k == 8) { g.A = (const bf16_t*)(ws + WS_G); g.Bt = (const bf16_t*)(ws + WS_WB); g.lda = 3072; g.K = 3072; S.init(T, DM, 3072, 3072, 0, G, c); E.mode = 2; E.O = (bf16_t*)(ws + WS_OB); E.ldc = DM; }
    else             { g.A = (const bf16_t*)(ws + WS_OB); g.Bt = (const bf16_t*)(ws + WS_WO); g.lda = DM; g.K = DM; S.init(T, DM, DM, DM, 0, G, c); E.mode = 3; }
    pg8::gemm_phase(lds, g, S, E);
}

__global__ void __launch_bounds__(512, 2) mk_fwd(Args args) {
    extern __shared__ __attribute__((aligned(16))) unsigned char shm[];
    LAS unsigned char* lds = (LAS unsigned char*)shm;
    cg::grid_group grid = cg::this_grid();
    volatile LAS unsigned* bst = (volatile LAS unsigned*)(lds + LDS_BYTES - 64);
    if (threadIdx.x < 2) bst[threadIdx.x] = 0u;
    __syncthreads();
    XcdBarrier xbar;
    { ArgsP ap0 = get_args(); xbar.bar = (unsigned*)(ap0->ws + WS_BAR); xbar.x = xb_xcc_id(); xbar.st = bst;
      if (blockIdx.x == 0) { u32x4* cw = (u32x4*)(ap0->ws + WS_CTL); for (int i = threadIdx.x; i < (int)(WS_CTL_BYTES / 16); i += 512) cw[i] = (u32x4){0u, 0u, 0u, 0u}; } }
    for (int step = 0; step < 10 * DEPTH; ++step) {
        const int l = step / 10, k = step - l * 10;
        if (k == 7 || k == 5) continue;
        if (false) continue;
        if (k == 1 || k == 3 || k == 4 || k == 8 || k == 9) { if (PH(2)) phase_gemm(l, k, lds); }
        else if (k == 0) { if (PH(0)) phase_prep(l, lds); }
        else if (k == 2) { if (PH(3)) phase_post_u(l); }
        else if (k == 5) { if (PH(5)) phase_post_a(l); }
        else if (k == 6) { if (PH(6)) phase_attn(l, lds); }
        if (k != 3 && step != 10 * DEPTH - 1) { if (step == 0) { grid.sync(); if (threadIdx.x == 0) (void)xb_add(&xbar.bar[XB_XCNT(xbar.x)], 1u); } else xcd_barrier(xbar); }
    }
}

extern "C" void kernel_launch(void* const* d_in, const int* in_sizes, int n_in, void* d_out, int out_size, void* d_ws, size_t ws_size, hipStream_t stream) {
    static int grid = 0;
    if (grid == 0) {
        if (n_in != 18 || in_sizes[0] != T * DM || out_size != T * DM || ws_size < WS_END) {
            fprintf(stderr, "kernel_launch: unexpected shapes / workspace (n_in %d, in0 %d, out %d, ws %zu, need %zu)\n", n_in, n_in > 0 ? in_sizes[0] : -1, out_size, ws_size, (size_t)WS_END);
            grid = -1; return; }
        int dev = 0, cus = 0, per_cu = 0;
        hipGetDevice(&dev);
        hipDeviceGetAttribute(&cus, hipDeviceAttributeMultiprocessorCount, dev);
        if (hipFuncSetAttribute((const void*)mk_fwd, hipFuncAttributeMaxDynamicSharedMemorySize, LDS_BYTES) != hipSuccess) { fprintf(stderr, "kernel_launch: hipFuncSetAttribute failed\n"); grid = -1; return; }
        if (hipOccupancyMaxActiveBlocksPerMultiprocessor(&per_cu, (const void*)mk_fwd, 512, LDS_BYTES) != hipSuccess || per_cu < 1) { fprintf(stderr, "kernel_launch: occupancy query gave %d\n", per_cu); per_cu = 1; }
        (void)hipGetLastError();
        grid = cus * 1;
    }
    if (grid < 0) return;
    Args a{};
    for (int i = 0; i < 18; ++i) a.in[i] = (const float*)d_in[i];
    a.out = (float*)d_out; a.ws = (unsigned char*)d_ws;
    void* kargs[] = {&a};
    hipError_t e = hipLaunchCooperativeKernel((const void*)mk_fwd, dim3(grid), dim3(512), kargs, LDS_BYTES, stream);
    if (e != hipSuccess) fprintf(stderr, "kernel_launch: cooperative launch failed: %s (grid %d)\n", hipGetErrorString(e), grid);
}
```

```cpp
#include <hip/hip_runtime.h>
#include <hip/hip_cooperative_groups.h>
#include <cstdio>
#include <cstdint>
namespace cg = cooperative_groups;
#ifndef PH_MASK
#define PH_MASK 0xFFFF
#endif
#define PH(k) ((PH_MASK >> (k)) & 1)

#define DI __device__ __forceinline__
#define LAS __attribute__((address_space(3)))
typedef unsigned short bf16_t;
typedef short bf16x8 __attribute__((ext_vector_type(8)));
typedef short s16x4 __attribute__((ext_vector_type(4)));
typedef float f32x4 __attribute__((ext_vector_type(4)));
typedef float f32x16 __attribute__((ext_vector_type(16)));
typedef unsigned u32x4 __attribute__((ext_vector_type(4)));

constexpr int T = 16384, SEQ = 4096, DM = 2048, DIN = 16192, NU = 16384, DEPTH = 2;
constexpr int UC_CQ = 0, UC_CKV = 512, UC_AZ = 1024, UC_BQ = 2048, UC_BK = 3072, UC_BV = 4096, UC_BZ = 5120,
              UC_CQ2 = 6144, UC_CK = 7168, UC_CV = 8192, UC_CZ = 9216, UC_GATE = 10240;
constexpr float EPS = 1e-6f, LOG2E = 1.4426950408889634f;

constexpr size_t al256(size_t x) { return (x + 255) / 256 * 256; }
constexpr size_t WS_CTL = 0;
constexpr size_t WS_BAR = 1024;
constexpr size_t WS_CTL_BYTES = 32768;
constexpr size_t WS_ROPE = WS_CTL_BYTES;
constexpr size_t WS_WIN = al256(WS_ROPE + (size_t)SEQ * 80 * 4);
constexpr size_t WS_WUQ = WS_WIN + (size_t)NU * DM * 2;
constexpr size_t WS_WUKV = WS_WUQ + (size_t)1536 * 512 * 2;
constexpr size_t WS_WB = WS_WUKV + (size_t)2048 * 256 * 2;
constexpr size_t WS_WO = WS_WB + (size_t)3 * 2048 * 1024 * 2;
constexpr size_t WS_U = WS_WO + (size_t)2048 * 2048 * 2;
constexpr size_t WS_R1 = WS_U + (size_t)T * NU * 2;
constexpr size_t WS_QA = WS_R1 + (size_t)T * 2048 * 2;
constexpr size_t WS_KVA = WS_QA + (size_t)T * 1536 * 2;
constexpr size_t WS_KA = WS_KVA + (size_t)T * 2048 * 2;
constexpr size_t WS_OB = WS_KA + (size_t)T * 1536 * 2;
constexpr size_t WS_G = WS_OB + (size_t)T * 2048 * 2;
constexpr size_t WS_END = WS_G + (size_t)T * 3072 * 2;

constexpr int LDS_BYTES = 147456;
constexpr int ATT_MISC = 4 * 16384 + 3 * 24576;
constexpr int ATT_BIAS = ATT_MISC + 2048;
constexpr int ATT_QW = ATT_BIAS + 1024;

DI unsigned pk2(float lo, float hi) { unsigned r; asm volatile("v_cvt_pk_bf16_f32 %0, %1, %2" : "=v"(r) : "v"(lo), "v"(hi)); return r; }
DI bf16_t f2bf(float x) { unsigned u = __float_as_uint(x); u += 0x7fffu + ((u >> 16) & 1u); return (bf16_t)(u >> 16); }
DI void unpack8(const u32x4 v, float (&f)[8]) {
    f[0] = __uint_as_float(v.x << 16); f[1] = __uint_as_float(v.x & 0xffff0000u);
    f[2] = __uint_as_float(v.y << 16); f[3] = __uint_as_float(v.y & 0xffff0000u);
    f[4] = __uint_as_float(v.z << 16); f[5] = __uint_as_float(v.z & 0xffff0000u);
    f[6] = __uint_as_float(v.w << 16); f[7] = __uint_as_float(v.w & 0xffff0000u);
}
DI u32x4 pack8(const float (&f)[8]) { u32x4 o; o.x = pk2(f[0], f[1]); o.y = pk2(f[2], f[3]); o.z = pk2(f[4], f[5]); o.w = pk2(f[6], f[7]); return o; }
DI void load8f(const float* p, float (&f)[8]) { const f32x4 a = *(const f32x4*)p, b = *(const f32x4*)(p + 4); f[0] = a.x; f[1] = a.y; f[2] = a.z; f[3] = a.w; f[4] = b.x; f[5] = b.y; f[6] = b.z; f[7] = b.w; }
DI float sumsq8(const float (&f)[8]) { float s = 0.f;
#pragma unroll
    for (int j = 0; j < 8; ++j) s += f[j] * f[j];
    return s; }
DI float xsum(float v, int lo, int hi) {
#pragma unroll
    for (int o = lo; o <= hi; o <<= 1) v += __shfl_xor(v, o);
    return v; }
DI float sigmoidf_(float v) { return __builtin_amdgcn_rcpf(1.f + __expf(-v)); }

namespace pg8 {
constexpr int BM = 256, BK = 64, HALF = 128, HTB = HALF * BK * 2, STAGE_BYTES = 8 * HTB, NXCD = 8, WGM = 4;
DI int lds_byte(int r, int c) { const int st = (r >> 4) * 2 + (c >> 5), rr = r & 15, cc = c & 31, ob = rr * 64 + cc * 2; return st * 1024 + (ob ^ (((ob >> 9) & 1) << 5)); }
DI void stage_rc(int b, int& R, int& C) { const int st = b / 1024, sb = b % 1024, swz = sb ^ (((sb >> 9) & 1) << 5); R = (st >> 1) * 16 + swz / 64; C = (st & 1) * 32 + (swz % 64) / 2; }
DI int perm32(int rho) { const int n = rho >> 4, i = rho & 15; return 8 * (i >> 2) + 4 * n + (i & 3); }

struct Unit { int pm, pn, sub; size_t aoff, boff; };
struct Gemm { const bf16_t* A; const bf16_t* Bt; int lda, K; };

DI void tile_of(int wgid, int nM, int nN, int& pm, int& pn) {
    const int nwg = nM * nN;
    { const int q = nwg / NXCD, r = nwg % NXCD, xcd = wgid % NXCD, off = wgid / NXCD; wgid = (xcd < r ? xcd * (q + 1) : r * (q + 1) + (xcd - r) * q) + off; }
    const int nig = WGM * nN, gid = wgid / nig, fm = gid * WGM, gsz = (nM - fm) < WGM ? (nM - fm) : WGM;
    pm = fm + ((wgid % nig) % gsz); pn = (wgid % nig) / gsz;
}
struct Sched {
    int nM, nN, nwg, G, c, lda, K, triple;
    DI void init(int M, int N, int lda_, int K_, int triple_, int G_, int c_) { nM = M / BM; nN = N / BM; nwg = nM * nN; G = G_; c = c_; lda = lda_; K = K_; triple = triple_; }
    DI bool next(int i, Unit& u) const {
        const int j = triple ? i / 3 : i; const long L = (long)j * G + c; if (L >= nwg) return false;
        tile_of((int)L, nM, nN, u.pm, u.pn); u.sub = triple ? i - 3 * j : 0;
        if (triple) { u.aoff = ((size_t)u.pm * BM * 3072 + (size_t)u.sub * 1024) * 2; u.boff = ((size_t)u.sub * 2048 + (size_t)u.pn * BM) * 1024 * 2; }
        else { u.aoff = (size_t)u.pm * BM * lda * 2; u.boff = (size_t)u.pn * BM * K * 2; }
        return true;
    }
};

struct Epi {
    static constexpr bool PERM = true;
    int mode, act_by_pn, ldc; bf16_t* O; const bf16_t* U; float* YB; const float* Xin; float* Out;
    bf16_t* KAo; const float* gk; LAS float* part;
    DI void operator()(const f32x4 (&acc)[2][2][4][2], const Unit& u, int wr, int wc, int fr, int fq) const {
        const int pn = u.pn;
        const int row0 = u.pm * BM + wr * 64 + fr, col0 = pn * BM + wc * 32 + 8 * fq;
        if (mode == 0) {
            const int act = !act_by_pn ? 0 : ((pn >= 40) ? 2 : (((pn >= 4 && pn < 8) || (pn >= 20 && pn < 24) || (pn >= 36 && pn < 40)) ? 1 : 0));
#pragma unroll
            for (int ai = 0; ai < 2; ++ai)
#pragma unroll
                for (int m = 0; m < 4; ++m) { bf16_t* rowp = O + (size_t)(row0 + ai * HALF + m * 16) * ldc + col0;
#pragma unroll
                    for (int bj = 0; bj < 2; ++bj) { f32x4 v0 = acc[ai][bj][m][0], v1 = acc[ai][bj][m][1];
                        if (act == 1) {
#pragma unroll
                            for (int j = 0; j < 4; ++j) { v0[j] = v0[j] * sigmoidf_(v0[j]); v1[j] = v1[j] * sigmoidf_(v1[j]); }
                        } else if (act == 2) {
#pragma unroll
                            for (int j = 0; j < 4; ++j) { v0[j] = sigmoidf_(v0[j]); v1[j] = sigmoidf_(v1[j]); }
                        }
                        u32x4 w; w.x = pk2(v0[0], v0[1]); w.y = pk2(v0[2], v0[3]); w.z = pk2(v1[0], v1[1]); w.w = pk2(v1[2], v1[3]);
                        *(u32x4*)(rowp + bj * HALF) = w; } }
        } else if (mode == 4) {
            float ss[2][4];
#pragma unroll
            for (int ai = 0; ai < 2; ++ai)
#pragma unroll
                for (int m = 0; m < 4; ++m) { const f32x4 a0 = acc[ai][0][m][0], a1 = acc[ai][0][m][1];
                    float v = (a0.x * a0.x + a0.y * a0.y) + (a0.z * a0.z + a0.w * a0.w) + (a1.x * a1.x + a1.y * a1.y) + (a1.z * a1.z + a1.w * a1.w);
                    v += __shfl_xor(v, 16); v += __shfl_xor(v, 32); ss[ai][m] = v; }
            if (fq == 0) {
#pragma unroll
                for (int ai = 0; ai < 2; ++ai)
#pragma unroll
                    for (int m = 0; m < 4; ++m) part[(ai * HALF + wr * 64 + m * 16 + fr) * 4 + wc] = ss[ai][m];
            }
            asm volatile("s_waitcnt lgkmcnt(0)" ::: "memory");
            __builtin_amdgcn_s_barrier();
            asm volatile("" ::: "memory");
            float gk8[8]; load8f(gk + wc * 32 + 8 * fq, gk8);
#pragma unroll
            for (int ai = 0; ai < 2; ++ai)
#pragma unroll
                for (int m = 0; m < 4; ++m) { const int rl = ai * HALF + wr * 64 + m * 16 + fr; const size_t row = (size_t)(u.pm * BM + rl);
                    const f32x4 pv = *(const LAS f32x4*)(part + rl * 4);
                    const float rs = 1.0f / sqrtf(((pv.x + pv.y) + (pv.z + pv.w)) * (1.0f / 128) + EPS);
                    { const f32x4 v0 = acc[ai][0][m][0], v1 = acc[ai][0][m][1];
                      u32x4 w; w.x = pk2(v0[0] * rs * gk8[0], v0[1] * rs * gk8[1]); w.y = pk2(v0[2] * rs * gk8[2], v0[3] * rs * gk8[3]);
                      w.z = pk2(v1[0] * rs * gk8[4], v1[1] * rs * gk8[5]); w.w = pk2(v1[2] * rs * gk8[6], v1[3] * rs * gk8[7]);
                      *(u32x4*)(KAo + row * 1536 + pn * 192 + wc * 32 + 8 * fq) = w; }
                    { const f32x4 v0 = acc[ai][1][m][0], v1 = acc[ai][1][m][1];
                      u32x4 w; w.x = pk2(v0[0], v0[1]); w.y = pk2(v0[2], v0[3]); w.z = pk2(v1[0], v1[1]); w.w = pk2(v1[2], v1[3]);
                      *(u32x4*)(O + row * ldc + col0 + HALF) = w; } }
        } else if (mode == 2) {
#pragma unroll
            for (int ai = 0; ai < 2; ++ai) { u32x4 gv[4][2];
#pragma unroll
                for (int m = 0; m < 4; ++m)
#pragma unroll
                    for (int bj = 0; bj < 2; ++bj) gv[m][bj] = *(const u32x4*)(U + (size_t)(row0 + ai * HALF + m * 16) * NU + UC_GATE + 2 * 2048 + col0 + bj * HALF);
#pragma unroll
                for (int m = 0; m < 4; ++m) { const size_t row = (size_t)(row0 + ai * HALF + m * 16);
#pragma unroll
                    for (int bj = 0; bj < 2; ++bj) { const int col = col0 + bj * HALF;
                        float g[8]; unpack8(gv[m][bj], g);
#pragma unroll
                        for (int j = 0; j < 8; ++j) g[j] = fmaxf(g[j], 1e-30f);
                        const f32x4 a0 = acc[ai][bj][m][0], a1 = acc[ai][bj][m][1];
                        u32x4 w; w.x = pk2(a0[0] * g[0], a0[1] * g[1]); w.y = pk2(a0[2] * g[2], a0[3] * g[3]); w.z = pk2(a1[0] * g[4], a1[1] * g[5]); w.w = pk2(a1[2] * g[6], a1[3] * g[7]);
                        *(u32x4*)(O + row * DM + col) = w; } }
                __builtin_amdgcn_sched_barrier(0); }
        } else {
#pragma unroll
            for (int ai = 0; ai < 2; ++ai) { f32x4 xv[4][2][2];
#pragma unroll
                for (int m = 0; m < 4; ++m)
#pragma unroll
                    for (int bj = 0; bj < 2; ++bj)
#pragma unroll
                        for (int n = 0; n < 2; ++n) xv[m][bj][n] = __builtin_nontemporal_load((const f32x4*)(Xin + (size_t)(row0 + ai * HALF + m * 16) * DM + col0 + bj * HALF + n * 4));
#pragma unroll
                for (int m = 0; m < 4; ++m)
#pragma unroll
                    for (int bj = 0; bj < 2; ++bj)
#pragma unroll
                        for (int n = 0; n < 2; ++n) *(f32x4*)(Out + (size_t)(row0 + ai * HALF + m * 16) * DM + col0 + bj * HALF + n * 4) = xv[m][bj][n] + acc[ai][bj][m][n];
                __builtin_amdgcn_sched_barrier(0); }
        }
    }
    DI void rescale(f32x4 (&acc)[2][2][4][2], const Unit& u, int seg, int wr, int wc, int fr, int fq) const {
        int row0 = u.pm * BM + wr * 64 + fr, col0 = u.pn * BM + wc * 32 + 8 * fq;
        asm volatile("" : "+v"(row0), "+v"(col0));
#pragma unroll
        for (int ai = 0; ai < 2; ++ai)
#pragma unroll
        for (int mh = 0; mh < 2; ++mh) { u32x4 rr[2][4];
#pragma unroll
            for (int mm = 0; mm < 2; ++mm) { const bf16_t* gp = U + (size_t)(row0 + ai * HALF + (mh * 2 + mm) * 16) * NU + UC_GATE + (seg - 1) * 2048 + col0;
                rr[mm][0] = *(const u32x4*)(gp); rr[mm][1] = *(const u32x4*)(gp + HALF); rr[mm][2] = *(const u32x4*)(gp + 2048); rr[mm][3] = *(const u32x4*)(gp + 2048 + HALF); }
            asm volatile("s_waitcnt vmcnt(0)" ::: "memory");
#pragma unroll
            for (int mm = 0; mm < 2; ++mm)
#pragma unroll
                for (int bj = 0; bj < 2; ++bj) { const int m = mh * 2 + mm;
                    float g[8], gn[8]; unpack8(rr[mm][bj], g); unpack8(rr[mm][2 + bj], gn);
#pragma unroll
                    for (int j = 0; j < 8; ++j) g[j] = fmaxf(g[j], 1e-30f) * __builtin_amdgcn_rcpf(fmaxf(gn[j], 1e-30f));
                    f32x4 a0 = acc[ai][bj][m][0], a1 = acc[ai][bj][m][1];
                    a0.x *= g[0]; a0.y *= g[1]; a0.z *= g[2]; a0.w *= g[3];
                    a1.x *= g[4]; a1.y *= g[5]; a1.z *= g[6]; a1.w *= g[7];
                    acc[ai][bj][m][0] = a0; acc[ai][bj][m][1] = a1; }
            __builtin_amdgcn_sched_barrier(0); }
    }
};

DI void gemm_phase(LAS unsigned char* lds, const Gemm g, const Sched& S, const Epi& E) {
    int tid_ = threadIdx.x; asm volatile("" : "+v"(tid_));
    const int tid = tid_, wid = __builtin_amdgcn_readfirstlane(tid >> 6), lane = tid & 63, wr = wid >> 2, wc = wid & 3, fr = lane & 15, fq = lane >> 4;
    const int K = g.K, lda = g.lda, nt = K / BK;
    unsigned voffA[2], voffB[2];
#pragma unroll
    for (int i = 0; i < 2; ++i) { int R, C; stage_rc(tid * 16 + i * 8192, R, C); const int Rb = Epi::PERM ? ((R & ~31) + perm32(R & 31)) : R;
        voffA[i] = (unsigned)(R * lda + C) * 2u; voffB[i] = (unsigned)(Rb * K + C) * 2u; }
    const size_t kstep = (size_t)(BK * 2);
    const size_t hstepA = (size_t)HALF * lda * 2, hstepB = (size_t)HALF * K * 2;
    const unsigned ldsw = (unsigned)wid * 1024u;
    const int aoff = lds_byte(wr * 64 + fr, fq * 8), boff = lds_byte(wc * 32 + fr, fq * 8);
#define PG8_SA(b, h) (((b) * 2 + (h)) * HTB)
#define PG8_SB(b, h) ((4 + (b) * 2 + (h)) * HTB)
#define PG8_STAGE(bufoff, gbase, voff) do { _Pragma("unroll") for (int _i = 0; _i < 2; ++_i) \
        __builtin_amdgcn_global_load_lds((const unsigned*)((const char*)(gbase) + (voff)[_i]), (LAS unsigned*)(lds + (bufoff) + ldsw + _i * 8192), 16, 0, 0); } while (0)
#define PG8_LDA(dst, b, h) do { _Pragma("unroll") for (int m = 0; m < 4; ++m) _Pragma("unroll") for (int k = 0; k < 2; ++k) dst[m][k] = *(const LAS bf16x8*)(lds + PG8_SA(b, h) + aoff + m * 2048 + k * 1024); } while (0)
#define PG8_LDB(dst, b, h) do { _Pragma("unroll") for (int n = 0; n < 2; ++n) _Pragma("unroll") for (int k = 0; k < 2; ++k) dst[n][k] = *(const LAS bf16x8*)(lds + PG8_SB(b, h) + boff + n * 2048 + k * 1024); } while (0)
#define PG8_MMA(ai, bj, At, Bt) do { __builtin_amdgcn_s_setprio(1); _Pragma("unroll") for (int m = 0; m < 4; ++m) _Pragma("unroll") for (int n = 0; n < 2; ++n) _Pragma("unroll") for (int k = 0; k < 2; ++k) \
        acc[ai][bj][m][n] = __builtin_amdgcn_mfma_f32_16x16x32_bf16(Bt[n][k], At[m][k], acc[ai][bj][m][n], 0, 0, 0); __builtin_amdgcn_s_setprio(0); } while (0)
#define PG8_WAIT_V(n) asm volatile("s_waitcnt vmcnt(" #n ")" ::: "memory")
#define PG8_WAIT_L(n) asm volatile("s_waitcnt lgkmcnt(" #n ")" ::: "memory")
#define PG8_BAR __builtin_amdgcn_s_barrier()
#define PG8_SCHED __builtin_amdgcn_sched_barrier(0)
    Unit cur, nxt; int ui = 0;
    if (!S.next(0, cur)) return;
    f32x4 acc[2][2][4][2];
#pragma unroll
    for (int a = 0; a < 2; ++a)
#pragma unroll
        for (int b = 0; b < 2; ++b)
#pragma unroll
            for (int m = 0; m < 4; ++m)
#pragma unroll
                for (int n = 0; n < 2; ++n) acc[a][b][m][n] = (f32x4){0.f, 0.f, 0.f, 0.f};
    bf16x8 At[4][2], B0[2][2], B1[2][2];
    const char* cA = (const char*)g.A + cur.aoff; const char* cB = (const char*)g.Bt + cur.boff;
    PG8_STAGE(PG8_SB(0, 0), cB, voffB); PG8_STAGE(PG8_SB(0, 1), cB + hstepB, voffB); PG8_STAGE(PG8_SA(0, 0), cA, voffA); PG8_STAGE(PG8_SA(0, 1), cA + hstepA, voffA);
    if (wr == 1) PG8_BAR;
    PG8_WAIT_V(2); PG8_BAR;
    PG8_STAGE(PG8_SB(1, 0), cB + kstep, voffB); PG8_STAGE(PG8_SA(1, 0), cA + kstep, voffA); PG8_STAGE(PG8_SB(1, 1), cB + hstepB + kstep, voffB);
    PG8_WAIT_V(6); PG8_BAR;
    for (;;) {
        const bool has_next = S.next(ui + 1, nxt);
        const char* nA = has_next ? (const char*)g.A + nxt.aoff : cA; const char* nB = has_next ? (const char*)g.Bt + nxt.boff : cB;
        for (int t = 0; t < nt; t += 2) {
            if (E.mode == 2 && (t == 16 || t == 32)) E.rescale(acc, cur, t >> 4, wr, wc, fr, fq);
            const bool last = (t == nt - 2);
            const char* a1 = cA + (size_t)(t + 1) * kstep;
            const char* a2 = last ? nA : cA + (size_t)(t + 2) * kstep; const char* b2 = last ? nB : cB + (size_t)(t + 2) * kstep;
            const char* a3 = a2 + kstep; const char* b3 = b2 + kstep;
            PG8_LDB(B0, 0, 0); PG8_LDB(B1, 0, 1); PG8_SCHED; PG8_LDA(At, 0, 0); PG8_STAGE(PG8_SA(1, 1), a1 + hstepA, voffA);
            PG8_WAIT_V(8); PG8_WAIT_L(0); PG8_BAR; PG8_MMA(0, 0, At, B0); PG8_MMA(0, 1, At, B1); PG8_BAR; PG8_SCHED;
            PG8_LDA(At, 0, 1); PG8_STAGE(PG8_SB(0, 0), b2, voffB); PG8_STAGE(PG8_SB(0, 1), b2 + hstepB, voffB); PG8_STAGE(PG8_SA(0, 0), a2, voffA);
            PG8_WAIT_V(8); PG8_WAIT_L(0); PG8_BAR; PG8_MMA(1, 0, At, B0); PG8_MMA(1, 1, At, B1); PG8_BAR; PG8_SCHED;
            PG8_LDB(B0, 1, 0); PG8_LDB(B1, 1, 1); PG8_SCHED; PG8_LDA(At, 1, 0); PG8_STAGE(PG8_SA(0, 1), a2 + hstepA, voffA);
            PG8_WAIT_V(8); PG8_WAIT_L(0); PG8_BAR; PG8_MMA(0, 0, At, B0); PG8_MMA(0, 1, At, B1); PG8_BAR; PG8_SCHED;
            PG8_LDA(At, 1, 1); PG8_STAGE(PG8_SB(1, 0), b3, voffB); PG8_STAGE(PG8_SB(1, 1), b3 + hstepB, voffB); PG8_STAGE(PG8_SA(1, 0), a3, voffA);
            PG8_WAIT_V(8); PG8_WAIT_L(0); PG8_BAR; PG8_MMA(1, 0, At, B0); PG8_MMA(1, 1, At, B1); PG8_BAR; PG8_SCHED;
        }
        if (wr == 0) PG8_BAR;
        E(acc, cur, wr, wc, fr, fq);
        if (!has_next) break;
#pragma unroll
        for (int a = 0; a < 2; ++a)
#pragma unroll
            for (int b = 0; b < 2; ++b)
#pragma unroll
                for (int m = 0; m < 4; ++m)
#pragma unroll
                    for (int n = 0; n < 2; ++n) acc[a][b][m][n] = (f32x4){0.f, 0.f, 0.f, 0.f};
        cur = nxt; cA = nA; cB = nB; ++ui;
        if (wr == 1) PG8_BAR;
    }
    PG8_WAIT_V(0);
    PG8_BAR;
#undef PG8_SA
#undef PG8_SB
#undef PG8_STAGE
#undef PG8_LDA
#undef PG8_LDB
#undef PG8_MMA
#undef PG8_WAIT_V
#undef PG8_WAIT_L
#undef PG8_BAR
#undef PG8_SCHED
}
}

DI int crow(int r, int hi) { return (r & 3) + 8 * (r >> 2) + 4 * hi; }
DI int v_st(int k, int c) { const int kk = (k & ~0xC) | ((k & 4) << 1) | ((k & 8) >> 1); return ((kk >> 3) * 4 + (c >> 5)) * 512 + ((kk & 7) * 32 + (c & 31)) * 2; }
DI int v_rd_base(int lane) { return ((lane & 3) << 3) | (((lane >> 2) & 3) << 6) | (((lane >> 4) & 1) << 5) | (((lane >> 5) & 1) << 8); }
constexpr int v_rd_off(int d0, int ks, int half) { return d0 * 512 + ks * 4096 + half * 2048; }
template <int OFF> DI s16x4 tr_read(int vb) { s16x4 r; asm volatile("ds_read_b64_tr_b16 %0, %1 offset:%2" : "=&v"(r) : "v"(vb), "i"(OFF) : "memory"); return r; }
template <int D0> DI void pv_one(f32x16& od, int vb, bf16x8 pa0, bf16x8 pa1, bf16x8 pa2, bf16x8 pa3) {
    const s16x4 l0 = tr_read<v_rd_off(D0, 0, 0)>(vb), h0 = tr_read<v_rd_off(D0, 0, 1)>(vb), l1 = tr_read<v_rd_off(D0, 1, 0)>(vb), h1 = tr_read<v_rd_off(D0, 1, 1)>(vb);
    const s16x4 l2 = tr_read<v_rd_off(D0, 2, 0)>(vb), h2 = tr_read<v_rd_off(D0, 2, 1)>(vb), l3 = tr_read<v_rd_off(D0, 3, 0)>(vb), h3 = tr_read<v_rd_off(D0, 3, 1)>(vb);
    asm volatile("s_waitcnt lgkmcnt(0)" ::: "memory"); __builtin_amdgcn_sched_barrier(0);
#define PK(L, H) (bf16x8){L[0], L[1], L[2], L[3], H[0], H[1], H[2], H[3]}
    od = __builtin_amdgcn_mfma_f32_32x32x16_bf16(pa0, PK(l0, h0), od, 0, 0, 0);
    od = __builtin_amdgcn_mfma_f32_32x32x16_bf16(pa1, PK(l1, h1), od, 0, 0, 0);
    od = __builtin_amdgcn_mfma_f32_32x32x16_bf16(pa2, PK(l2, h2), od, 0, 0, 0);
    od = __builtin_amdgcn_mfma_f32_32x32x16_bf16(pa3, PK(l3, h3), od, 0, 0, 0);
#undef PK
}
template <int DQK> DI int kswz(int row, int cb) { return row * (DQK * 2) + (cb ^ ((row & 7) << 4)); }

template <int DQK, bool BIAS, int ldq, int ldk, int ldv, int ldo>
DI void attn_unit(const float* __restrict__ gq, const float* __restrict__ ropec, const float* __restrict__ ropes, const int pos0,
                  const bf16_t* __restrict__ Qb, const bf16_t* __restrict__ Kb, const bf16_t* __restrict__ Vb, bf16_t* __restrict__ Ob,
                  const int blk_lo, const int blk_hi, const int cw, const float C, LAS unsigned char* lds,
                  const int epi, const bf16_t* __restrict__ Zb, const bf16_t* __restrict__ O0b, const float lam, const float post, const float* __restrict__ gsub) {
    constexpr int NKC = DQK / 64, ND = DQK / 16, SHV = 16384, SHK = 64 * DQK * 2, KOFF = 4 * SHV, RB = DQK * 2;
    constexpr float THR_L2 = 6.0f;
    int tid_ = threadIdx.x; asm volatile("" : "+v"(tid_));
    const int tid = tid_, wid = __builtin_amdgcn_readfirstlane(tid >> 6), lane = tid & 63, r32 = lane & 31, hi = lane >> 5;
    const bool late = wid >= 4;
    LAS float* misc = (LAS float*)(lds + ATT_MISC) + wid * 64; LAS float* li_l = misc; LAS float* al_l = misc + 32;
    const LAS float* bias_l = (const LAS float*)(lds + ATT_BIAS);
    const int w_lo = BIAS ? (cw > 8 ? cw - 8 : 0) : 0, w_hi = cw;
    float m_reg = -1e30f, l_reg = 0.f;
    f32x16 o[4];
#pragma unroll
    for (int d = 0; d < 4; ++d)
#pragma unroll
        for (int r = 0; r < 16; ++r) o[d][r] = 0.f;
    bf16x8 qr[ND];
    { const bf16_t* Qw = Qb + (size_t)(wid * 32 + r32) * ldq + hi * 8;
#pragma unroll
      for (int d0 = 0; d0 < ND; ++d0) qr[d0] = *(const bf16x8*)(Qw + d0 * 16);
      { const int pos = pos0 + wid * 32 + r32;
        float qf[ND][8]; float ssn = 0.f, ssr = 0.f;
#pragma unroll
        for (int d0 = 0; d0 < ND; ++d0) { unpack8(__builtin_bit_cast(u32x4, qr[d0]), qf[d0]); const float sq = sumsq8(qf[d0]); if (DQK == 192 && d0 >= 8) ssr += sq; else ssn += sq; }
        { auto rr = __builtin_amdgcn_permlane32_swap(__float_as_uint(ssn), __float_as_uint(ssn), false, false); ssn = __uint_as_float(rr[0]) + __uint_as_float(rr[1]); }
        if (DQK == 192) { auto rr = __builtin_amdgcn_permlane32_swap(__float_as_uint(ssr), __float_as_uint(ssr), false, false); ssr = __uint_as_float(rr[0]) + __uint_as_float(rr[1]); }
        const float rsn = 1.0f / sqrtf(ssn * (DQK == 64 ? (1.0f / 64) : (1.0f / 128)) + EPS), rsr = 1.0f / sqrtf(ssr * (1.0f / 64) + EPS);
#pragma unroll
        for (int d0 = 0; d0 < ND; ++d0) { float g[8]; load8f(gq + d0 * 16 + hi * 8, g); const float rs = (DQK == 192 && d0 >= 8) ? rsr : rsn;
#pragma unroll
            for (int j = 0; j < 8; ++j) qf[d0][j] = qf[d0][j] * rs * g[j]; }
        if (DQK == 64) {
            float cs[8], sn[8]; load8f(ropec + pos * 8, cs); load8f(ropes + pos * 8, sn);
#pragma unroll
            for (int j = 0; j < 8; ++j) { auto rr = __builtin_amdgcn_permlane32_swap(__float_as_uint(qf[0][j]), __float_as_uint(qf[0][j]), false, false);
                const float other = __uint_as_float(hi ? rr[0] : rr[1]);
                qf[0][j] = hi ? qf[0][j] * cs[j] + other * sn[j] : qf[0][j] * cs[j] - other * sn[j]; }
        }
        if (DQK == 192) {
#pragma unroll
            for (int dd = 0; dd < 2; ++dd) { float cs[8], sn[8]; load8f(ropec + pos * 32 + dd * 16 + hi * 8, cs); load8f(ropes + pos * 32 + dd * 16 + hi * 8, sn);
#pragma unroll
                for (int j = 0; j < 8; ++j) { const float x1 = qf[(DQK == 192 ? 8 : 0) + dd][j], x2 = qf[(DQK == 192 ? 10 : 0) + dd][j];
                    qf[(DQK == 192 ? 8 : 0) + dd][j] = x1 * cs[j] - x2 * sn[j]; qf[(DQK == 192 ? 10 : 0) + dd][j] = x2 * cs[j] + x1 * sn[j]; } }
        }
#pragma unroll
        for (int d0 = 0; d0 < ND; ++d0) qr[d0] = __builtin_bit_cast(bf16x8, pack8(qf[d0]));
      }
#pragma unroll
      for (int d0 = 0; d0 < ND; ++d0) asm volatile("" : "+v"(qr[d0])); }
    unsigned goffK[NKC], goffV[2];
#pragma unroll
    for (int i = 0; i < NKC; ++i) { const int ob = (i * 8 + wid) * 1024 + lane * 16, row = ob / RB, cbs = ob - row * RB, cb = cbs ^ ((row & 7) << 4); goffK[i] = (unsigned)(row * ldk + (cb >> 1)); }
#pragma unroll
    for (int i = 0; i < 2; ++i) { const int ob = (i * 8 + wid) * 1024 + lane * 16, st = ob >> 9, w = (ob & 511) >> 1, kk = ((st >> 2) << 3) | (w >> 5);
        const int k = (kk & ~0xC) | ((kk & 4) << 1) | ((kk & 8) >> 1), c = (st & 3) * 32 + (w & 31); goffV[i] = (unsigned)(k * ldv + c); }
    const int vb0 = (int)(size_t)(lds) + v_rd_base(lane);
#define AT_DMA(t, kslot, vslot) do { const bf16_t* kp_ = Kb + (size_t)((t) * 64) * ldk; const bf16_t* vp_ = Vb + (size_t)((t) * 64) * ldv; \
        _Pragma("unroll") for (int i_ = 0; i_ < NKC; ++i_) __builtin_amdgcn_global_load_lds((const unsigned*)(kp_ + goffK[i_]), (LAS unsigned*)(lds + KOFF + (kslot) * SHK + (i_ * 8 + wid) * 1024), 16, 0, 0); \
        _Pragma("unroll") for (int i_ = 0; i_ < 2; ++i_) __builtin_amdgcn_global_load_lds((const unsigned*)(vp_ + goffV[i_]), (LAS unsigned*)(lds + (vslot) * SHV + (i_ * 8 + wid) * 1024), 16, 0, 0); } while (0)
#define AT_PV(vb_) do { __builtin_amdgcn_s_setprio(1); pv_one<0>(o[0], (vb_), pa0, pa1, pa2, pa3); pv_one<1>(o[1], (vb_), pa0, pa1, pa2, pa3); pv_one<2>(o[2], (vb_), pa0, pa1, pa2, pa3); pv_one<3>(o[3], (vb_), pa0, pa1, pa2, pa3); __builtin_amdgcn_s_setprio(0); } while (0)
    AT_DMA(blk_lo, 0, 0);
    if (blk_lo + 1 <= blk_hi) AT_DMA(blk_lo + 1, 1, 1);
    constexpr bool PIPE = (DQK == 64) && !BIAS;
    if constexpr (PIPE) {
        f32x16 pA0, pA1, pB0, pB1;
        bf16x8 pa0, pa1, pa2, pa3;
        int ksn = 0;
#define PQK(P0, P1, kslot_) do { __builtin_amdgcn_s_setprio(1); _Pragma("unroll") for (int r_ = 0; r_ < 16; ++r_) { P0[r_] = 0.f; P1[r_] = 0.f; } \
            const LAS unsigned char* Ks_ = lds + KOFF + (kslot_) * SHK; \
            _Pragma("unroll") for (int d0_ = 0; d0_ < ND; ++d0_) { const int cb_ = (d0_ * 16 + hi * 8) * 2; \
                const bf16x8 b0_ = *(const LAS bf16x8*)(Ks_ + kswz<DQK>(r32, cb_)); const bf16x8 b1_ = *(const LAS bf16x8*)(Ks_ + kswz<DQK>(32 + r32, cb_)); \
                P0 = __builtin_amdgcn_mfma_f32_32x32x16_bf16(b0_, qr[d0_], P0, 0, 0, 0); P1 = __builtin_amdgcn_mfma_f32_32x32x16_bf16(b1_, qr[d0_], P1, 0, 0, 0); } __builtin_amdgcn_s_setprio(0); } while (0)
#define PK4(P, BASE, OUT) do { unsigned a0 = pk2(P[BASE + 0], P[BASE + 1]), a1 = pk2(P[BASE + 2], P[BASE + 3]);   \
    unsigned b0 = pk2(P[BASE + 4], P[BASE + 5]), b1 = pk2(P[BASE + 6], P[BASE + 7]);                              \
    auto r0 = __builtin_amdgcn_permlane32_swap(a0, b0, false, false); auto r1 = __builtin_amdgcn_permlane32_swap(a1, b1, false, false); \
    u32x4 w = {r0[0], r1[0], r0[1], r1[1]}; OUT = *reinterpret_cast<bf16x8*>(&w); } while (0)
#define PSMPV(P0, P1, tt_) do { float mx_ = P0[0]; \
            _Pragma("unroll") for (int r_ = 1; r_ < 16; ++r_) mx_ = fmaxf(mx_, P0[r_]); \
            _Pragma("unroll") for (int r_ = 0; r_ < 16; ++r_) mx_ = fmaxf(mx_, P1[r_]); \
            { auto rr_ = __builtin_amdgcn_permlane32_swap(__float_as_uint(mx_), __float_as_uint(mx_), false, false); mx_ = fmaxf(__uint_as_float(rr_[0]), __uint_as_float(rr_[1])); } \
            mx_ *= C; float alpha_ = 1.f; const bool keep_ = __all(mx_ - m_reg <= THR_L2); \
            if (!keep_) { const float mn_ = fmaxf(m_reg, mx_); alpha_ = __builtin_amdgcn_exp2f(m_reg - mn_); m_reg = mn_; } \
            { const float nm_ = -m_reg; _Pragma("unroll") for (int r_ = 0; r_ < 16; ++r_) { P0[r_] = __builtin_amdgcn_exp2f(fmaf(P0[r_], C, nm_)); P1[r_] = __builtin_amdgcn_exp2f(fmaf(P1[r_], C, nm_)); } } \
            float ps_ = 0.f; _Pragma("unroll") for (int r_ = 0; r_ < 16; ++r_) ps_ += P0[r_]; _Pragma("unroll") for (int r_ = 0; r_ < 16; ++r_) ps_ += P1[r_]; \
            { auto rr_ = __builtin_amdgcn_permlane32_swap(__float_as_uint(ps_), __float_as_uint(ps_), false, false); ps_ = __uint_as_float(rr_[0]) + __uint_as_float(rr_[1]); } \
            l_reg = l_reg * alpha_ + ps_; \
            PK4(P0, 0, pa0); PK4(P0, 8, pa1); PK4(P1, 0, pa2); PK4(P1, 8, pa3); \
            if (!keep_) { if (hi == 0) al_l[r32] = alpha_; asm volatile("s_waitcnt lgkmcnt(0)" ::: "memory"); \
                _Pragma("unroll") for (int r_ = 0; r_ < 16; ++r_) { const float a_ = al_l[crow(r_, hi)]; _Pragma("unroll") for (int d_ = 0; d_ < 4; ++d_) o[d_][r_] *= a_; } } \
            const int vb_ = vb0 + (((tt_) - blk_lo) & 3) * SHV; AT_PV(vb_); } while (0)
#define PSTEP(tt_, PC0, PC1, PN0, PN1) do { \
            if ((tt_) + 2 <= blk_hi) asm volatile("s_waitcnt vmcnt(3) lgkmcnt(0)" ::: "memory"); else asm volatile("s_waitcnt vmcnt(0) lgkmcnt(0)" ::: "memory"); \
            __builtin_amdgcn_s_barrier(); asm volatile("" ::: "memory"); \
            if ((tt_) + 3 <= blk_hi) { const int s3_ = (ksn >= 1) ? ksn - 1 : 2; AT_DMA((tt_) + 3, s3_, ((tt_) + 3 - blk_lo) & 3); } \
            if ((tt_) + 1 >= w_lo && (tt_) + 1 <= w_hi) PQK(PN0, PN1, ksn); \
            if ((tt_) >= w_lo && (tt_) <= w_hi) PSMPV(PC0, PC1, (tt_)); \
            ksn = (ksn == 2) ? 0 : ksn + 1; } while (0)
        for (int t = blk_lo - 1; t <= blk_hi; t += 2) {
            PSTEP(t, pA0, pA1, pB0, pB1);
            if (t + 1 <= blk_hi) PSTEP(t + 1, pB0, pB1, pA0, pA1);
        }
#undef PSTEP
#undef PSMPV
#undef PK4
#undef PQK
    } else {
    int slot = 0;
    bf16x8 pa0, pa1, pa2, pa3;
    bool pend = false; int pend_vb = 0;
    for (int t = blk_lo; t <= blk_hi; ++t) {
        if (t + 1 <= blk_hi) { if constexpr (NKC == 1) asm volatile("s_waitcnt vmcnt(3) lgkmcnt(0)" ::: "memory"); else if constexpr (NKC == 2) asm volatile("s_waitcnt vmcnt(4) lgkmcnt(0)" ::: "memory"); else asm volatile("s_waitcnt vmcnt(5) lgkmcnt(0)" ::: "memory"); }
        else asm volatile("s_waitcnt vmcnt(0) lgkmcnt(0)" ::: "memory");
        __builtin_amdgcn_s_barrier();
        asm volatile("" ::: "memory");
        if (t + 2 <= blk_hi) { const int s2 = (slot >= 1) ? slot - 1 : 2; AT_DMA(t + 2, s2, (t + 2 - blk_lo) & 3); }
        if (pend) { AT_PV(pend_vb); pend = false; }
        if (t >= w_lo && t <= w_hi) {
            f32x16 p0, p1;
#pragma unroll
            for (int r = 0; r < 16; ++r) { p0[r] = 0.f; p1[r] = 0.f; }
            const LAS unsigned char* Ks = lds + KOFF + slot * SHK;
            __builtin_amdgcn_s_setprio(1);
#pragma unroll
            for (int d0 = 0; d0 < ND; ++d0) { const int cb = (d0 * 16 + hi * 8) * 2;
                const bf16x8 b0 = *(const LAS bf16x8*)(Ks + kswz<DQK>(r32, cb));
                const bf16x8 b1 = *(const LAS bf16x8*)(Ks + kswz<DQK>(32 + r32, cb));
                p0 = __builtin_amdgcn_mfma_f32_32x32x16_bf16(b0, qr[d0], p0, 0, 0, 0);
                p1 = __builtin_amdgcn_mfma_f32_32x32x16_bf16(b1, qr[d0], p1, 0, 0, 0); }
            __builtin_amdgcn_s_setprio(0);
            float mx;
            if (BIAS) {
                const int dch = cw - t;
                if (dch >= 3) { const float bc = bias_l[191];
#pragma unroll
                    for (int r = 0; r < 16; ++r) { p0[r] = fmaf(p0[r], C, bc); p1[r] = fmaf(p1[r], C, bc); }
                } else { const int base = dch * 64 + (wid & 1) * 32 + r32 + 63;
#pragma unroll
                    for (int r = 0; r < 16; ++r) { const int kk = crow(r, hi); const int i0 = base - kk, i1 = base - kk - 32;
                        p0[r] = fmaf(p0[r], C, bias_l[i0 > 191 ? 191 : i0]); p1[r] = fmaf(p1[r], C, bias_l[i1 > 191 ? 191 : i1]); }
                }
            }
            mx = p0[0];
#pragma unroll
            for (int r = 1; r < 16; ++r) mx = fmaxf(mx, p0[r]);
#pragma unroll
            for (int r = 0; r < 16; ++r) mx = fmaxf(mx, p1[r]);
            { auto rr = __builtin_amdgcn_permlane32_swap(__float_as_uint(mx), __float_as_uint(mx), false, false);
              mx = fmaxf(__uint_as_float(rr[0]), __uint_as_float(rr[1])); }
            if (!BIAS) mx *= C;
            float alpha = 1.f;
            const bool keep = __all(mx - m_reg <= THR_L2);
            if (!keep) { const float mn = fmaxf(m_reg, mx); alpha = __builtin_amdgcn_exp2f(m_reg - mn); m_reg = mn; }
            if (BIAS) {
#pragma unroll
                for (int r = 0; r < 16; ++r) { p0[r] = __builtin_amdgcn_exp2f(p0[r] - m_reg); p1[r] = __builtin_amdgcn_exp2f(p1[r] - m_reg); }
            } else { const float nm = -m_reg;
#pragma unroll
                for (int r = 0; r < 16; ++r) { p0[r] = __builtin_amdgcn_exp2f(fmaf(p0[r], C, nm)); p1[r] = __builtin_amdgcn_exp2f(fmaf(p1[r], C, nm)); }
            }
            float ps = 0.f;
#pragma unroll
            for (int r = 0; r < 16; ++r) ps += p0[r];
#pragma unroll
            for (int r = 0; r < 16; ++r) ps += p1[r];
            { auto rr = __builtin_amdgcn_permlane32_swap(__float_as_uint(ps), __float_as_uint(ps), false, false);
              ps = __uint_as_float(rr[0]) + __uint_as_float(rr[1]); }
            l_reg = l_reg * alpha + ps;
#define PK4(P, BASE, OUT) do { unsigned a0 = pk2(P[BASE + 0], P[BASE + 1]), a1 = pk2(P[BASE + 2], P[BASE + 3]);   \
    unsigned b0 = pk2(P[BASE + 4], P[BASE + 5]), b1 = pk2(P[BASE + 6], P[BASE + 7]);                              \
    auto r0 = __builtin_amdgcn_permlane32_swap(a0, b0, false, false); auto r1 = __builtin_amdgcn_permlane32_swap(a1, b1, false, false); \
    u32x4 w = {r0[0], r1[0], r0[1], r1[1]}; OUT = *reinterpret_cast<bf16x8*>(&w); } while (0)
            PK4(p0, 0, pa0); PK4(p0, 8, pa1); PK4(p1, 0, pa2); PK4(p1, 8, pa3);
#undef PK4
            if (!keep) {
                if (hi == 0) al_l[r32] = alpha;
                asm volatile("s_waitcnt lgkmcnt(0)" ::: "memory");
#pragma unroll
                for (int r = 0; r < 16; ++r) { const float a = al_l[crow(r, hi)];
#pragma unroll
                    for (int d = 0; d < 4; ++d) o[d][r] *= a; }
            }
            const int vb = vb0 + ((t - blk_lo) & 3) * SHV;
            if (late) { pend = true; pend_vb = vb; }
            else AT_PV(vb);
        }
        slot = (slot == 2) ? 0 : slot + 1;
    }
    if (pend) AT_PV(pend_vb);
    }
#undef AT_DMA
#undef AT_PV
    if (hi == 0) li_l[r32] = l_reg;
    asm volatile("s_waitcnt lgkmcnt(0)" ::: "memory");
    float rli[16];
#pragma unroll
    for (int r = 0; r < 16; ++r) rli[r] = __builtin_amdgcn_rcpf(li_l[crow(r, hi)]);
    bf16_t* Ow = Ob + (size_t)(wid * 32) * ldo;
    if (epi == 0) {
#pragma unroll
        for (int r = 0; r < 16; ++r) { const int orow = crow(r, hi);
#pragma unroll
            for (int d0 = 0; d0 < 4; ++d0) Ow[(size_t)orow * ldo + d0 * 32 + r32] = f2bf(o[d0][r] * rli[r]); }
    } else if (epi == 1) {
        const bf16_t* Zw = Zb + (size_t)(wid * 32) * NU;
        bf16_t zr[16][4];
#pragma unroll
        for (int r = 0; r < 16; ++r) { const int orow = crow(r, hi);
#pragma unroll
            for (int d0 = 0; d0 < 4; ++d0) zr[r][d0] = Zw[(size_t)orow * NU + d0 * 32 + r32]; }
#pragma unroll
        for (int r = 0; r < 16; ++r) { const int orow = crow(r, hi);
#pragma unroll
            for (int d0 = 0; d0 < 4; ++d0) { const float z = __uint_as_float((unsigned)zr[r][d0] << 16);
                Ow[(size_t)orow * ldo + d0 * 32 + r32] = f2bf(o[d0][r] * rli[r] * z); } }
    } else {
        const bf16_t* Zw = Zb + (size_t)(wid * 32) * NU; const bf16_t* O0w = O0b + (size_t)(wid * 32) * ldo;
        float gs[4];
#pragma unroll
        for (int d0 = 0; d0 < 4; ++d0) gs[d0] = gsub[d0 * 32 + r32] * post;
        bf16_t zr[16][4], o0r[16][4];
#pragma unroll
        for (int r = 0; r < 16; ++r) { const int orow = crow(r, hi);
#pragma unroll
            for (int d0 = 0; d0 < 4; ++d0) { zr[r][d0] = Zw[(size_t)orow * NU + d0 * 32 + r32]; o0r[r][d0] = O0w[(size_t)orow * ldo + d0 * 32 + r32]; } }
#pragma unroll
        for (int r = 0; r < 16; ++r) { const int orow = crow(r, hi); float d[4]; float ss = 0.f;
#pragma unroll
            for (int d0 = 0; d0 < 4; ++d0) { const float o0 = __uint_as_float((unsigned)o0r[r][d0] << 16);
                d[d0] = o0 - lam * (o[d0][r] * rli[r]); ss += d[d0] * d[d0]; }
            ss = xsum(ss, 1, 16);
            const float rs = 1.0f / sqrtf(ss * (1.0f / 128) + EPS);
#pragma unroll
            for (int d0 = 0; d0 < 4; ++d0) { const float z = __uint_as_float((unsigned)zr[r][d0] << 16);
                Ow[(size_t)orow * ldo + d0 * 32 + r32] = f2bf(d[d0] * rs * gs[d0] * z); } }
    }
    __syncthreads();
}

#define XB_TMO      128
#define XB_XCNT(j)  (256  + 64 * (j))
#define XB_XSUB(j)  (1280 + 64 * (j))
#define XB_XGEN(j)  (2304 + 64 * (j))
#define XB_TOP      3328
#define XB_TOPGEN   3392
#define XCD_BAR_WORDS 3456
#define XB_SPIN_CAP (1u << 20)
DI unsigned xb_ld(unsigned* p)              { return __hip_atomic_load(p, __ATOMIC_RELAXED, __HIP_MEMORY_SCOPE_AGENT); }
DI unsigned xb_add(unsigned* p, unsigned v) { return __hip_atomic_fetch_add(p, v, __ATOMIC_RELAXED, __HIP_MEMORY_SCOPE_AGENT); }
DI unsigned xb_xcc_id() { return (unsigned)__builtin_amdgcn_s_getreg((3 << 11) | 20) & 0xFu; }
#define XB_SPIN(cond, bar) do { unsigned _sp = 0; while (cond) {   \
    if ((++_sp & 255u) == 0u) { if (xb_ld(&(bar)[XB_TMO])) break; if (_sp > XB_SPIN_CAP) { atomicAdd(&(bar)[XB_TMO], 1u); break; } } } } while (0)
struct XcdBarrier { unsigned* bar; unsigned x; volatile LAS unsigned* st; };
DI XcdBarrier xcd_barrier_post(unsigned* bar, volatile LAS unsigned* st) {
    XcdBarrier b; b.bar = bar; b.x = xb_xcc_id(); b.st = st;
    if (threadIdx.x == 0) (void)xb_add(&bar[XB_XCNT(b.x)], 1u);
    return b;
}
DI void xcd_barrier_complete(unsigned* bar, unsigned x, unsigned& nloc, unsigned& nx) {
    const unsigned G = gridDim.x * gridDim.y * gridDim.z;
    unsigned sum, cnt, mine, sp = 0u;
    for (;;) {
        sum = 0u; cnt = 0u; mine = 0u;
#pragma unroll
        for (unsigned j = 0; j < 16; ++j) { const unsigned c = xb_ld(&bar[XB_XCNT(j)]); sum += c; cnt += (c > 0u) ? 1u : 0u; mine = (j == x) ? c : mine; }
        if (sum == G) break;
        __builtin_amdgcn_s_sleep(1);
        if ((++sp & 255u) == 0u) { if (xb_ld(&bar[XB_TMO])) break; if (sp > XB_SPIN_CAP) { atomicAdd(&bar[XB_TMO], 1u); break; } }
    }
    nloc = mine > 0u ? mine : 1u; nx = cnt > 0u ? cnt : 1u;
}
DI void xcd_barrier(const XcdBarrier& b) {
    asm volatile("s_waitcnt vmcnt(0)" ::: "memory");
    __syncthreads();
    if (threadIdx.x == 0) {
        unsigned* bar = b.bar;
        __builtin_amdgcn_s_waitcnt(0);
        unsigned nloc = b.st[0], nx = b.st[1];
        if (nloc == 0u) { xcd_barrier_complete(bar, b.x, nloc, nx); b.st[0] = nloc; b.st[1] = nx; }
        const unsigned old = xb_add(&bar[XB_XSUB(b.x)], 1u);
        const unsigned gen = old / nloc;
        if (old + 1u == (gen + 1u) * nloc) {
            __builtin_amdgcn_fence(__ATOMIC_RELEASE, "agent");
            asm volatile("s_waitcnt vmcnt(0)" ::: "memory");
            const unsigned og = xb_add(&bar[XB_TOP], 1u);
            const unsigned tg = og / nx;
            if (og + 1u == (tg + 1u) * nx) xb_add(&bar[XB_TOPGEN], 1u);
            else XB_SPIN(xb_ld(&bar[XB_TOPGEN]) == tg, bar);
            __builtin_amdgcn_fence(__ATOMIC_ACQUIRE, "agent");
            xb_add(&bar[XB_XGEN(b.x)], 1u);
            asm volatile("s_waitcnt vmcnt(0)" ::: "memory");
        } else {
            XB_SPIN(xb_ld(&bar[XB_XGEN(b.x)]) == gen, bar);
            __builtin_amdgcn_fence(__ATOMIC_ACQUIRE, "agent");
            asm volatile("s_waitcnt vmcnt(0)" ::: "memory");
        }
    }
    __syncthreads();
}

struct Args {
    const float* in[18];
    float* out; unsigned char* ws;
};

DI void transpose_item(const float* __restrict__ W, int K, int N, bf16_t* __restrict__ WT, int ldw, int koff, bool remap, LAS float* scr, int item, int lane) {
    const int nblk = N / 32, kb = item / nblk, nb = item - kb * nblk, k0 = 64 * kb, n0 = 32 * nb;
    float v[32];
    const float* src = W + (size_t)(k0 + (lane >> 5)) * N + n0 + (lane & 31);
#pragma unroll
    for (int i = 0; i < 32; ++i) v[i] = src[(size_t)(2 * i) * N];
#pragma unroll
    for (int i = 0; i < 32; ++i) scr[(2 * i + (lane >> 5)) * 33 + (lane & 31)] = v[i];
    asm volatile("s_waitcnt lgkmcnt(0)" ::: "memory");
    int d0 = n0; if (remap && n0 >= 832) d0 += 192;
    const int c = lane & 7;
#pragma unroll
    for (int j = 0; j < 4; ++j) { const int n = (lane >> 3) + 8 * j; const LAS float* s = scr + (8 * c) * 33 + n;
        u32x4 o; o.x = pk2(s[0 * 33], s[1 * 33]); o.y = pk2(s[2 * 33], s[3 * 33]); o.z = pk2(s[4 * 33], s[5 * 33]); o.w = pk2(s[6 * 33], s[7 * 33]);
        *(u32x4*)(WT + (size_t)(d0 + n) * ldw + koff + k0 + 8 * c) = o; }
    asm volatile("s_waitcnt lgkmcnt(0)" ::: "memory");
}

typedef const __attribute__((address_space(4))) Args* ArgsP;
DI ArgsP get_args() { ArgsP ap = (ArgsP)__builtin_amdgcn_kernarg_segment_ptr(); asm volatile("" : "+s"(ap)); return ap; }

DI void phase_prep(const int l, LAS unsigned char* lds) {
    ArgsP ap = get_args();
    int tid_ = threadIdx.x; asm volatile("" : "+v"(tid_));
    const int tid = tid_, lane = tid & 63, wid = __builtin_amdgcn_readfirstlane(tid >> 6);
    const int G = gridDim.x, gw = blockIdx.x * 8 + wid, NGW = G * 8;
    unsigned char* ws = ap->ws;
    bf16_t* WIN = (bf16_t*)(ws + WS_WIN);
    if (l == 0) {
        float* ropeT = (float*)(ws + WS_ROPE);
        for (int idx = blockIdx.x * 512 + tid; idx < SEQ * 40; idx += G * 512) {
            const int pos = idx / 40, k = idx - pos * 40;
            float inv; if (k < 32) inv = 1.0f / powf(10000.0f, (float)(2 * k) / 64.0f); else inv = 1.0f / powf(500000.0f, (float)(2 * (k - 32)) / 16.0f);
            const float ang = (float)pos * inv;
            double rev = (double)ang * 0.15915494309189535; rev -= floor(rev);
            const float fr = (float)rev; const float cs = __builtin_amdgcn_cosf(fr), sn = __builtin_amdgcn_sinf(fr);
            if (k < 32) { ropeT[pos * 32 + k] = cs; ropeT[SEQ * 32 + pos * 32 + k] = sn; }
            else { ropeT[SEQ * 64 + pos * 8 + (k - 32)] = cs; ropeT[SEQ * 72 + pos * 8 + (k - 32)] = sn; }
        }
    }
    for (int i = blockIdx.x * 512 + tid; i < 192 * DM / 8; i += G * 512) *(u32x4*)(WIN + (size_t)832 * DM + (size_t)i * 8) = (u32x4){0u, 0u, 0u, 0u};
    {
        const float* w_in = ap->in[2] + (size_t)l * DM * DIN;
        const float* a_w_uq = ap->in[5] + (size_t)l * 512 * 1536; const float* a_w_ukv = ap->in[6] + (size_t)l * 256 * 2048;
        const float* w_branch = ap->in[16] + (size_t)l * 3 * 1024 * 2048; const float* w_out = ap->in[17] + (size_t)l * DM * DM;
        bf16_t* WUQ = (bf16_t*)(ws + WS_WUQ); bf16_t* WUKV = (bf16_t*)(ws + WS_WUKV); bf16_t* WB = (bf16_t*)(ws + WS_WB); bf16_t* WO = (bf16_t*)(ws + WS_WO);
        LAS float* scr = (LAS float*)(lds) + wid * (64 * 33);
        constexpr int I_IN = (DM / 64) * (DIN / 32), I_UQ = (512 / 64) * (1536 / 32), I_UKV = (256 / 64) * (2048 / 32), I_BR = (1024 / 64) * (2048 / 32), I_OUT = (DM / 64) * (DM / 32);
        constexpr int NITEMS = I_IN + I_UQ + I_UKV + 3 * I_BR + I_OUT;
        for (int it = gw; it < NITEMS; it += NGW) {
            int r = it;
            if (r < I_IN) { transpose_item(w_in, DM, DIN, WIN, DM, 0, true, scr, r, lane); continue; } r -= I_IN;
            if (r < I_UQ) { transpose_item(a_w_uq, 512, 1536, WUQ, 512, 0, false, scr, r, lane); continue; } r -= I_UQ;
            if (r < I_UKV) { transpose_item(a_w_ukv, 256, 2048, WUKV, 256, 0, false, scr, r, lane); continue; } r -= I_UKV;
            if (r < 3 * I_BR) { const int n = r / I_BR; transpose_item(w_branch + (size_t)n * 1024 * 2048, 1024, 2048, WB, 3072, n * 1024, false, scr, r - n * I_BR, lane); continue; } r -= 3 * I_BR;
            transpose_item(w_out, DM, DM, WO, DM, 0, false, scr, r, lane);
        }
    }
    {
        const float* xin = (l == 0) ? ap->in[0] : ap->out; const float* g_pre = ap->in[1] + (size_t)l * DM; bf16_t* H = (bf16_t*)(ws + WS_R1);
        for (int t = gw; t < T; t += NGW) {
            const float* xr = xin + (size_t)t * DM; f32x4 v[8]; float ss = 0.f;
#pragma unroll
            for (int j = 0; j < 8; ++j) { v[j] = *(const f32x4*)(xr + j * 256 + lane * 4); ss += (v[j].x * v[j].x + v[j].y * v[j].y) + (v[j].z * v[j].z + v[j].w * v[j].w); }
            ss = xsum(ss, 1, 32);
            const float rs = 1.0f / sqrtf(ss * (1.0f / DM) + EPS);
#pragma unroll
            for (int j = 0; j < 8; ++j) { const f32x4 g = *(const f32x4*)(g_pre + j * 256 + lane * 4);
                uint2 o; o.x = pk2(v[j].x * rs * g.x, v[j].y * rs * g.y); o.y = pk2(v[j].z * rs * g.z, v[j].w * rs * g.w);
                *(uint2*)(H + (size_t)t * DM + j * 256 + lane * 4) = o; }
        }
    }
}

DI void phase_post_u(const int l) {
    ArgsP ap = get_args();
    int tid_ = threadIdx.x; asm volatile("" : "+v"(tid_));
    const int tid = tid_, lane = tid & 63, wid = __builtin_amdgcn_readfirstlane(tid >> 6);
    const int gw = blockIdx.x * 8 + wid, NGW = gridDim.x * 8;
    unsigned char* ws = ap->ws;
    const float* ropeT = (const float*)(ws + WS_ROPE);
    const float* cosA = ropeT; const float* sinA = ropeT + SEQ * 32; const float* cosB = ropeT + SEQ * 64; const float* sinB = ropeT + SEQ * 72;
    bf16_t* U = (bf16_t*)(ws + WS_U); bf16_t* KA = (bf16_t*)(ws + WS_KA);
    const bool is_kr = (lane >= 32 && lane < 40);
    float g_cq[8], g_kv[8], g_bq[8], g_bk[8], g_cq2[8], g_ck[8];
    load8f(ap->in[3] + l * 512 + lane * 8, g_cq);
    load8f(is_kr ? ap->in[8] + l * 192 + 128 + (lane - 32) * 8 : ap->in[4] + l * 256 + (lane & 31) * 8, g_kv);
    load8f(ap->in[9] + l * 64 + (lane & 7) * 8, g_bq); load8f(ap->in[10] + l * 64 + (lane & 7) * 8, g_bk);
    load8f(ap->in[13] + l * 128 + (lane & 15) * 8, g_cq2); load8f(ap->in[14] + l * 128 + (lane & 15) * 8, g_ck);
    const int iA = (lane & 3) * 8, l7 = lane & 7;
    for (int t = gw; t < T; t += NGW) {
        bf16_t* ur = U + (size_t)t * NU; const int pos = t & (SEQ - 1);
        u32x4 raw[10];
        raw[0] = *(const u32x4*)(ur + UC_CQ + lane * 8); raw[1] = *(const u32x4*)(ur + UC_CKV + lane * 8);
#pragma unroll
        for (int hf = 0; hf < 2; ++hf) { raw[4 + hf] = *(const u32x4*)(ur + UC_BK + hf * 512 + lane * 8); raw[8 + hf] = *(const u32x4*)(ur + UC_CK + hf * 512 + lane * 8); }
        float csA[8], snA[8], csB[8], snB[8];
        load8f(cosA + pos * 32 + iA, csA); load8f(sinA + pos * 32 + iA, snA); load8f(cosB + pos * 8, csB); load8f(sinB + pos * 8, snB);
        float f[8];
        {
            unpack8(raw[0], f);
            const float rs = 1.0f / sqrtf(xsum(sumsq8(f), 1, 32) * (1.0f / 512) + EPS);
#pragma unroll
            for (int j = 0; j < 8; ++j) f[j] = f[j] * rs * g_cq[j];
            *(u32x4*)(ur + UC_CQ + lane * 8) = pack8(f);
        }
        {
            unpack8(raw[1], f);
            const float s8 = xsum(sumsq8(f), 1, 4), s32 = xsum(s8, 8, 16);
            const float rs = is_kr ? 1.0f / sqrtf(s8 * (1.0f / 64) + EPS) : 1.0f / sqrtf(s32 * (1.0f / 256) + EPS);
#pragma unroll
            for (int j = 0; j < 8; ++j) f[j] = f[j] * rs * g_kv[j];
            float yp[8];
#pragma unroll
            for (int j = 0; j < 8; ++j) yp[j] = __shfl_xor(f[j], 4);
            if (lane < 32) *(u32x4*)(ur + UC_CKV + lane * 8) = pack8(f);
            if (is_kr) {
                const bool first = (lane < 36); float o[8];
#pragma unroll
                for (int j = 0; j < 8; ++j) o[j] = first ? f[j] * csA[j] - yp[j] * snA[j] : f[j] * csA[j] + yp[j] * snA[j];
                const u32x4 pk = pack8(o);
#pragma unroll
                for (int h = 0; h < 8; ++h) *(u32x4*)(KA + (size_t)t * 1536 + h * 192 + 128 + (lane - 32) * 8) = pk;
            }
        }
#pragma unroll
        for (int w = 1; w < 2; ++w) {
#pragma unroll
            for (int hf = 0; hf < 2; ++hf) { bf16_t* p = ur + (w ? UC_BK : UC_BQ) + hf * 512 + lane * 8;
                unpack8(raw[2 + 2 * w + hf], f);
                const float rs = 1.0f / sqrtf(xsum(sumsq8(f), 1, 4) * (1.0f / 64) + EPS);
#pragma unroll
                for (int j = 0; j < 8; ++j) f[j] = f[j] * rs * (w ? g_bk[j] : g_bq[j]);
                float yp[8];
#pragma unroll
                for (int j = 0; j < 8; ++j) yp[j] = __shfl_xor(f[j], 1);
                if (l7 < 2) {
#pragma unroll
                    for (int j = 0; j < 8; ++j) f[j] = (l7 == 0) ? f[j] * csB[j] - yp[j] * snB[j] : f[j] * csB[j] + yp[j] * snB[j]; }
                *(u32x4*)p = pack8(f); } }
#pragma unroll
        for (int w = 1; w < 2; ++w) {
#pragma unroll
            for (int hf = 0; hf < 2; ++hf) { bf16_t* p = ur + (w ? UC_CK : UC_CQ2) + hf * 512 + lane * 8;
                unpack8(raw[6 + 2 * w + hf], f);
                const float rs = 1.0f / sqrtf(xsum(sumsq8(f), 1, 8) * (1.0f / 128) + EPS);
#pragma unroll
                for (int j = 0; j < 8; ++j) f[j] = f[j] * rs * (w ? g_ck[j] : g_cq2[j]);
                *(u32x4*)p = pack8(f); } }
    }
}

DI void phase_post_a(const int l) {
    ArgsP ap = get_args();
    int tid_ = threadIdx.x; asm volatile("" : "+v"(tid_));
    const int tid = tid_, lane = tid & 63, wid = __builtin_amdgcn_readfirstlane(tid >> 6);
    const int gw = blockIdx.x * 8 + wid, NGW = gridDim.x * 8;
    unsigned char* ws = ap->ws;
    const float* ropeT = (const float*)(ws + WS_ROPE);
    const float* cosA = ropeT; const float* sinA = ropeT + SEQ * 32;
    bf16_t* QA = (bf16_t*)(ws + WS_QA); bf16_t* KVA = (bf16_t*)(ws + WS_KVA); bf16_t* KA = (bf16_t*)(ws + WS_KA);
    const int slot = lane & 31, l31 = lane & 31; const bool act = slot < 24, rope = slot >= 16;
    float g_q[8], g_k[8];
    load8f(ap->in[7] + l * 192 + (act ? slot * 8 : 0), g_q); load8f(ap->in[8] + l * 192 + (l31 & 15) * 8, g_k);
    const int iA = (slot & 3) * 8;
    for (int t = gw; t < T; t += NGW) {
        const int pos = t & (SEQ - 1); float f[8];
        u32x4 rq[4], rk[4];
#pragma unroll
        for (int st = 0; st < 4; ++st) { const int head = st * 2 + (lane >> 5);
            rk[st] = *(const u32x4*)(KVA + (size_t)t * 2048 + head * 256 + l31 * 8); }
#pragma unroll
        for (int st = 0; st < 4; ++st) {
            const int head = st * 2 + (lane >> 5);
            unpack8(rk[st], f);
            const float rs = 1.0f / sqrtf(xsum(sumsq8(f), 1, 8) * (1.0f / 128) + EPS);
#pragma unroll
            for (int j = 0; j < 8; ++j) f[j] = f[j] * rs * g_k[j];
            if (l31 < 16) *(u32x4*)(KA + (size_t)t * 1536 + head * 192 + l31 * 8) = pack8(f);
        }
    }
}

DI int q_fetch(unsigned* ctr, LAS unsigned* qw) {
    if (threadIdx.x == 0) *qw = atomicAdd(ctr, 1u);
    __syncthreads();
    return __builtin_amdgcn_readfirstlane((int)*qw);
}
DI void phase_attn(const int l, LAS unsigned char* lds) {
    LAS unsigned* qw = (LAS unsigned*)(lds + ATT_QW);
#if PH(11)
    {
        ArgsP ap = get_args(); unsigned char* ws = ap->ws; unsigned* ctl = (unsigned*)(ws + WS_CTL) + l * 4;
        int tid = threadIdx.x; asm volatile("" : "+v"(tid)); const int wid = __builtin_amdgcn_readfirstlane(tid >> 6), lane = tid & 63;
        const float* b_lam = ap->in[11] + l * 256; const float* gsub = ap->in[12] + l * 128;
        const float lam_init = (l == 0) ? 0.2f : 0.35550906759f;
        float lam;
        { const float a = b_lam[lane] * b_lam[64 + lane], b2 = b_lam[128 + lane] * b_lam[192 + lane];
          lam = expf(xsum(a, 1, 32)) - expf(xsum(b2, 1, 32)) + lam_init; }
        for (;;) {
            const int idx = q_fetch(ctl + 1, qw);
            if (idx >= 512) break;
            const int qblk = 15 - (idx >> 5), r = idx & 31, b = r >> 3, h = r & 7; const size_t tok0 = (size_t)b * SEQ, q0 = tok0 + (size_t)qblk * 256;
            bf16_t* U = (bf16_t*)(ws + WS_U); bf16_t* Gt = (bf16_t*)(ws + WS_G);
            for (int c = 0; c < 2; ++c) {
                const int hc = h * 2 + c;
                bf16_t* outp = Gt + q0 * 3072 + 1024 + h * 128;
                attn_unit<64, false, NU, NU, NU, 3072>(ap->in[9] + l * 64, (const float*)(ws + WS_ROPE) + SEQ * 64, (const float*)(ws + WS_ROPE) + SEQ * 72, qblk * 256,
                                     U + q0 * NU + UC_BQ + hc * 64, U + tok0 * NU + UC_BK + hc * 64, U + tok0 * NU + UC_BV + h * 128,
                                     outp, 0, qblk * 4 + 3, qblk * 4 + (wid >> 1), 0.125f * LOG2E, lds,
                                     c ? 2 : 0, U + q0 * NU + UC_BZ + h * 128, outp, lam, 1.0f - lam_init, gsub);
            }
        }
    }
#endif
#if PH(10)
    {
        ArgsP ap = get_args(); unsigned char* ws = ap->ws; unsigned* ctl = (unsigned*)(ws + WS_CTL) + l * 4;
        int wid = threadIdx.x >> 6; asm volatile("" : "+v"(wid)); wid = __builtin_amdgcn_readfirstlane(wid);
        for (;;) {
            const int idx = q_fetch(ctl + 0, qw);
            if (idx >= 512) break;
            const int qblk = 15 - (idx >> 5), r = idx & 31, b = r >> 3, h = r & 7; const size_t tok0 = (size_t)b * SEQ, q0 = tok0 + (size_t)qblk * 256;
            bf16_t* QA = (bf16_t*)(ws + WS_QA); bf16_t* KVA = (bf16_t*)(ws + WS_KVA); bf16_t* KA = (bf16_t*)(ws + WS_KA); bf16_t* Gt = (bf16_t*)(ws + WS_G);
            const bf16_t* U = (const bf16_t*)(ws + WS_U);
            attn_unit<192, false, 1536, 1536, 2048, 3072>(ap->in[7] + l * 192, (const float*)(ws + WS_ROPE), (const float*)(ws + WS_ROPE) + SEQ * 32, qblk * 256,
                                  QA + q0 * 1536 + h * 192, KA + tok0 * 1536 + h * 192, KVA + tok0 * 2048 + h * 256 + 128,
                                  Gt + q0 * 3072 + h * 128, 0, qblk * 4 + 3, qblk * 4 + (wid >> 1), 0.07216878364870322f * LOG2E, lds,
                                  1, U + q0 * NU + UC_AZ + h * 128, nullptr, 0.f, 0.f, nullptr);
        }
    }
#endif
#if PH(12)
    {
        ArgsP ap = get_args(); unsigned char* ws = ap->ws; unsigned* ctl = (unsigned*)(ws + WS_CTL) + l * 4;
        const float* c_rel = ap->in[15] + l * 8 * 192;
        int wid = threadIdx.x >> 6; asm volatile("" : "+v"(wid)); wid = __builtin_amdgcn_readfirstlane(wid);
        for (;;) {
            const int idx = q_fetch(ctl + 2, qw);
            if (idx >= 512) break;
            const int qblk = 15 - (idx >> 5), r = idx & 31, b = r >> 3, h = r & 7; const size_t tok0 = (size_t)b * SEQ, q0 = tok0 + (size_t)qblk * 256;
            bf16_t* U = (bf16_t*)(ws + WS_U); bf16_t* Gt = (bf16_t*)(ws + WS_G);
            if (threadIdx.x < 192) ((LAS float*)(lds + ATT_BIAS))[threadIdx.x] = c_rel[h * 192 + threadIdx.x] * LOG2E;
            const int lo = qblk * 4 - 8;
            attn_unit<128, true, NU, NU, NU, 3072>(ap->in[13] + l * 128, nullptr, nullptr, qblk * 256,
                                 U + q0 * NU + UC_CQ2 + h * 128, U + tok0 * NU + UC_CK + h * 128, U + tok0 * NU + UC_CV + h * 128,
                                 Gt + q0 * 3072 + 2048 + h * 128, lo > 0 ? lo : 0, qblk * 4 + 3, qblk * 4 + (wid >> 1), 0.08838834764831845f * LOG2E, lds,
                                 1, U + q0 * NU + UC_CZ + h * 128, nullptr, 0.f, 0.f, nullptr);
        }
    }
#endif
}

DI void phase_gate(const int l) {
    ArgsP ap = get_args();
    int tid_ = threadIdx.x; asm volatile("" : "+v"(tid_));
    const int tid = tid_, lane = tid & 63, wid = __builtin_amdgcn_readfirstlane(tid >> 6);
    const int gw = blockIdx.x * 8 + wid, NGW = gridDim.x * 8;
    unsigned char* ws = ap->ws;
    const bf16_t* U = (const bf16_t*)(ws + WS_U); const bf16_t* OA = (const bf16_t*)(ws + WS_R1); const bf16_t* OC = OA + (size_t)T * 1024;
    const bf16_t* OB = (const bf16_t*)(ws + WS_OB); bf16_t* Gt = (bf16_t*)(ws + WS_QA);
    const float* b_lam = ap->in[11] + l * 256;
    const float lam_init = (l == 0) ? 0.2f : 0.35550906759f;
    float lam;
    { const float a = b_lam[lane] * b_lam[64 + lane], b = b_lam[128 + lane] * b_lam[192 + lane];
      lam = expf(xsum(a, 1, 32)) - expf(xsum(b, 1, 32)) + lam_init; }
    const int l15 = lane & 15;
    float g_sub[8]; load8f(ap->in[12] + l * 128 + l15 * 8, g_sub);
    for (int t = gw; t < T; t += NGW) {
        const bf16_t* ur = U + (size_t)t * NU; bf16_t* gr = Gt + (size_t)t * 3072; float f[8], z[8];
        u32x4 ra[2], za[2], rc[2], zc[2], rb0[2], rb1[2], zb[2];
#pragma unroll
        for (int hf = 0; hf < 2; ++hf) {
            ra[hf] = *(const u32x4*)(OA + (size_t)t * 1024 + hf * 512 + lane * 8); za[hf] = *(const u32x4*)(ur + UC_AZ + hf * 512 + lane * 8);
            rc[hf] = *(const u32x4*)(OC + (size_t)t * 1024 + hf * 512 + lane * 8); zc[hf] = *(const u32x4*)(ur + UC_CZ + hf * 512 + lane * 8);
            const int head = hf * 4 + (lane >> 4);
            rb0[hf] = *(const u32x4*)(OB + (size_t)t * 2048 + (2 * head) * 128 + l15 * 8); rb1[hf] = *(const u32x4*)(OB + (size_t)t * 2048 + (2 * head + 1) * 128 + l15 * 8);
            zb[hf] = *(const u32x4*)(ur + UC_BZ + head * 128 + l15 * 8); }
#pragma unroll
        for (int hf = 0; hf < 2; ++hf) {
            unpack8(ra[hf], f); unpack8(za[hf], z);
#pragma unroll
            for (int j = 0; j < 8; ++j) f[j] *= z[j];
            *(u32x4*)(gr + hf * 512 + lane * 8) = pack8(f);
            unpack8(rc[hf], f); unpack8(zc[hf], z);
#pragma unroll
            for (int j = 0; j < 8; ++j) f[j] *= z[j];
            *(u32x4*)(gr + 2048 + hf * 512 + lane * 8) = pack8(f);
        }
#pragma unroll
        for (int st = 0; st < 2; ++st) { const int head = st * 4 + (lane >> 4); float o1[8];
            unpack8(rb0[st], f); unpack8(rb1[st], o1);
#pragma unroll
            for (int j = 0; j < 8; ++j) f[j] = f[j] - lam * o1[j];
            const float rs = 1.0f / sqrtf(xsum(sumsq8(f), 1, 8) * (1.0f / 128) + EPS) * (1.0f - lam_init);
            unpack8(zb[st], z);
#pragma unroll
            for (int j = 0; j < 8; ++j) f[j] = f[j] * rs * g_sub[j] * z[j];
            *(u32x4*)(gr + 1024 + head * 128 + l15 * 8) = pack8(f); }
    }
}

DI void phase_gemm(const int l, const int k, LAS unsigned char* lds) {
    ArgsP ap = get_args();
    unsigned char* ws = ap->ws;
    bf16_t* U = (bf16_t*)(ws + WS_U);
    pg8::Gemm g; pg8::Sched S; pg8::Epi E;
    E.KAo = (bf16_t*)(ws + WS_KA); E.gk = ap->in[8] + l * 192; E.part = (LAS float*)(lds + 131072);
    E.U = U; E.YB = (float*)(U + UC_BQ); E.Xin = (l == 0) ? ap->in[0] : ap->out; E.Out = ap->out; E.act_by_pn = 0; E.mode = 0; E.ldc = NU; E.O = U;
    const int G = gridDim.x, c = blockIdx.x;
    if (k == 1)      { g.A = (const bf16_t*)(ws + WS_R1); g.Bt = (const bf16_t*)(ws + WS_WIN); g.lda = DM; g.K = DM; S.init(T, NU, DM, DM, 0, G, c); E.act_by_pn = 1; }
    else if (k == 3) { g.A = U + UC_CQ; g.Bt = (const bf16_t*)(ws + WS_WUQ); g.lda = NU; g.K = 512; S.init(T, 1536, NU, 512, 0, G, c); E.O = (bf16_t*)(ws + WS_QA); E.ldc = 1536; }
    else if (k == 4) { g.A = U + UC_CKV; g.Bt = (const bf16_t*)(ws + WS_WUKV); g.lda = NU; g.K = 256; S.init(T, 2048, NU, 256, 0, G, c); E.O = (bf16_t*)(ws + WS_KVA); E.ldc = 2048; E.mode = 4; }
    else if (k == 8) { g.A = (const bf16_t*)(ws + WS_G); g.Bt = (const bf16_t*)(ws + WS_WB); g.lda = 3072; g.K = 3072; S.init(T, DM, 3072, 3072, 0, G, c); E.mode = 2; E.O = (bf16_t*)(ws + WS_OB); E.ldc = DM; }
    else             { g.A = (const bf16_t*)(ws + WS_OB); g.Bt = (const bf16_t*)(ws + WS_WO); g.lda = DM; g.K = DM; S.init(T, DM, DM, DM, 0, G, c); E.mode = 3; }
    pg8::gemm_phase(lds, g, S, E);
}

__global__ void __launch_bounds__(512, 2) mk_fwd(Args args) {
    extern __shared__ __attribute__((aligned(16))) unsigned char shm[];
    LAS unsigned char* lds = (LAS unsigned char*)shm;
    cg::grid_group grid = cg::this_grid();
    volatile LAS unsigned* bst = (volatile LAS unsigned*)(lds + LDS_BYTES - 64);
    if (threadIdx.x < 2) bst[threadIdx.x] = 0u;
    __syncthreads();
    XcdBarrier xbar;
    { ArgsP ap0 = get_args(); xbar.bar = (unsigned*)(ap0->ws + WS_BAR); xbar.x = xb_xcc_id(); xbar.st = bst;
      if (blockIdx.x == 0) { u32x4* cw = (u32x4*)(ap0->ws + WS_CTL); for (int i = threadIdx.x; i < (int)(WS_CTL_BYTES / 16); i += 512) cw[i] = (u32x4){0u, 0u, 0u, 0u}; } }
    for (int step = 0; step < 10 * DEPTH; ++step) {
        const int l = step / 10, k = step - l * 10;
        if (k == 7 || k == 5) continue;
        if (false) continue;
        if (k == 1 || k == 3 || k == 4 || k == 8 || k == 9) { if (PH(2)) phase_gemm(l, k, lds); }
        else if (k == 0) { if (PH(0)) phase_prep(l, lds); }
        else if (k == 2) { if (PH(3)) phase_post_u(l); }
        else if (k == 5) { if (PH(5)) phase_post_a(l); }
        else if (k == 6) { if (PH(6)) phase_attn(l, lds); }
        if (k != 3 && step != 10 * DEPTH - 1) { if (step == 0) { grid.sync(); if (threadIdx.x == 0) (void)xb_add(&xbar.bar[XB_XCNT(xbar.x)], 1u); } else xcd_barrier(xbar); }
    }
}

extern "C" void kernel_launch(void* const* d_in, const int* in_sizes, int n_in, void* d_out, int out_size, void* d_ws, size_t ws_size, hipStream_t stream) {
    static int grid = 0;
    if (grid == 0) {
        if (n_in != 18 || in_sizes[0] != T * DM || out_size != T * DM || ws_size < WS_END) {
            fprintf(stderr, "kernel_launch: unexpected shapes / workspace (n_in %d, in0 %d, out %d, ws %zu, need %zu)\n", n_in, n_in > 0 ? in_sizes[0] : -1, out_size, ws_size, (size_t)WS_END);
            grid = -1; return; }
        int dev = 0, cus = 0, per_cu = 0;
        hipGetDevice(&dev);
        hipDeviceGetAttribute(&cus, hipDeviceAttributeMultiprocessorCount, dev);
        if (hipFuncSetAttribute((const void*)mk_fwd, hipFuncAttributeMaxDynamicSharedMemorySize, LDS_BYTES) != hipSuccess) { fprintf(stderr, "kernel_launch: hipFuncSetAttribute failed\n"); grid = -1; return; }
        if (hipOccupancyMaxActiveBlocksPerMultiprocessor(&per_cu, (const void*)mk_fwd, 512, LDS_BYTES) != hipSuccess || per_cu < 1) { fprintf(stderr, "kernel_launch: occupancy query gave %d\n", per_cu); per_cu = 1; }
        (void)hipGetLastError();
        grid = cus * 1;
    }
    if (grid < 0) return;
    Args a{};
    for (int i = 0; i < 18; ++i) a.in[i] = (const float*)d_in[i];
    a.out = (float*)d_out; a.ws = (unsigned char*)d_ws;
    void* kargs[] = {&a};
    hipError_t e = hipLaunchCooperativeKernel((const void*)mk_fwd, dim3(grid), dim3(512), kargs, LDS_BYTES, stream);
    if (e != hipSuccess) fprintf(stderr, "kernel_launch: cooperative launch failed: %s (grid %d)\n", hipGetErrorString(e), grid);
}
```
